# Optimizing an MI355X kernel written in HIP

```python
import math
import jax, jax.numpy as jnp
from jax import lax
import numpy as np

D_MODEL = 1024
BATCH = 8
SEQ = 4096
DEPTH = 4

HEAD_DIM = 64
N_META = 16
BLOCK = 128
NEG_INF = -1e30
SWA_WINDOW = 128
SWA_Q_HEADS = 8
SWA_KV_HEADS = 2
SWA_GROUP = SWA_Q_HEADS // SWA_KV_HEADS
FOX_HEADS = 8
LRU_WIDTH = D_MODEL // 2
LRU_BLOCKS = 8
LRU_BLOCK_DIM = LRU_WIDTH // LRU_BLOCKS
CONV_WIDTH = 4
LRU_C = 8.0
REL_BUCKETS = 32
REL_MAX_DIST = 128
D_FF = ((-(-8 * D_MODEL // 3)) + 255) // 256 * 256
N_BRANCH = 3
SPLIT_SIZES = (
    SWA_Q_HEADS * HEAD_DIM,
    SWA_KV_HEADS * HEAD_DIM,
    SWA_KV_HEADS * HEAD_DIM,
    FOX_HEADS * HEAD_DIM,
    FOX_HEADS * HEAD_DIM,
    FOX_HEADS * HEAD_DIM,
    FOX_HEADS,
    LRU_WIDTH,
    LRU_WIDTH,
    N_BRANCH * D_MODEL,
)
IN_COLS = sum(SPLIT_SIZES)

kernel_name = "hybrid_swa_fox_rglru_block"


def rms_norm(x, g, eps=1e-6):
    xf = x.astype(jnp.float32)
    y = xf * lax.rsqrt(jnp.mean(xf * xf, axis=-1, keepdims=True) + eps)
    return (y * g.astype(jnp.float32)).astype(x.dtype)


def pad_left(a, n):
    return jnp.pad(a, [(0, 0), (n, 0)] + [(0, 0)] * (a.ndim - 2))


def t5_bucket(dist):
    max_exact = REL_BUCKETS // 2
    d = jnp.maximum(dist, 0)
    scaled = jnp.log(jnp.maximum(d, 1).astype(jnp.float32) / max_exact) / math.log(REL_MAX_DIST / max_exact)
    large = jnp.minimum(max_exact + (scaled * (REL_BUCKETS - max_exact)).astype(jnp.int32), REL_BUCKETS - 1)
    return jnp.where(d < max_exact, d, large)


def swa_sink_attention(q, k, v, sinks, rel_table, n_pad):
    b, tp, _, dh = q.shape
    nb = tp // BLOCK
    qb = q.reshape(b, nb, BLOCK, SWA_KV_HEADS, SWA_GROUP, dh)

    def band(a):
        a = a.reshape(b, nb, BLOCK, SWA_KV_HEADS, dh)
        prev = jnp.pad(a, ((0, 0), (1, 0), (0, 0), (0, 0), (0, 0)))[:, :-1]
        return jnp.concatenate([prev, a], axis=2)

    k_band, v_band = band(k), band(v)
    s = jnp.einsum('bnqhgd,bnkhd->bnhgqk', qb, k_band).astype(jnp.float32) * (dh ** -0.5)
    q_idx = jnp.arange(BLOCK)[:, None]
    k_idx = jnp.arange(2 * BLOCK)[None, :]
    dist = q_idx + BLOCK - k_idx
    bias = rel_table.astype(jnp.float32)[t5_bucket(dist)]
    bias = bias.transpose(2, 0, 1).reshape(SWA_KV_HEADS, SWA_GROUP, BLOCK, 2 * BLOCK)
    key_abs = (jnp.arange(nb)[:, None] - 1) * BLOCK + k_idx
    mask = ((dist >= 0) & (dist < SWA_WINDOW))[None] & (key_abs >= n_pad)[:, None, :]
    s = jnp.where(mask[None, :, None, None], s + bias, NEG_INF)
    sink = sinks.astype(jnp.float32).reshape(SWA_KV_HEADS, SWA_GROUP)[None, None, :, :, None, None]
    m = jnp.maximum(jnp.max(s, axis=-1, keepdims=True), sink)
    p = jnp.exp(s - m)
    denom = jnp.sum(p, axis=-1, keepdims=True) + jnp.exp(sink - m)
    p = (p / denom).astype(v.dtype)
    o = jnp.einsum('bnhgqk,bnkhd->bnqhgd', p, v_band)
    return o.reshape(b, tp, SWA_Q_HEADS * dh)


def forgetting_attention(q, k, v, log_f, n_pad):
    b, tp, h, dh = q.shape
    nb = tp // BLOCK
    cum = jnp.cumsum(log_f, axis=1).transpose(0, 2, 1)
    k_pos = jnp.arange(tp)
    qb = q.reshape(b, nb, BLOCK, h, dh).transpose(1, 0, 2, 3, 4)
    cb = cum.reshape(b, h, nb, BLOCK).transpose(2, 0, 1, 3)

    def one_block(args):
        qi, ci, n = args
        s = jnp.einsum('bqhd,bkhd->bhqk', qi, k).astype(jnp.float32) * (dh ** -0.5)
        s = s + ci[..., :, None] - cum[:, :, None, :]
        q_pos = n * BLOCK + jnp.arange(BLOCK)
        mask = (k_pos[None, :] <= q_pos[:, None]) & (k_pos >= n_pad)[None, :]
        s = jnp.where(mask, s, NEG_INF)
        p = jax.nn.softmax(s, axis=-1).astype(v.dtype)
        return jnp.einsum('bhqk,bkhd->bqhd', p, v)

    o = lax.map(one_block, (qb, cb, jnp.arange(nb)))
    return o.transpose(1, 0, 2, 3, 4).reshape(b, tp, h * dh)


def causal_depthwise_conv(x, w, bias):
    t = x.shape[1]
    xp = jnp.pad(x, ((0, 0), (CONV_WIDTH - 1, 0), (0, 0)))
    out = xp[:, 0:t] * w[0]
    for i in range(1, CONV_WIDTH):
        out = out + xp[:, i:i + t] * w[i]
    return out + bias


def rg_lru(x, w_r, b_r, w_i, b_i, lam):
    b, t, c = x.shape
    xb = x.reshape(b, t, LRU_BLOCKS, LRU_BLOCK_DIM)
    r = jax.nn.sigmoid(jnp.einsum('bthi,hij->bthj', xb, w_r).reshape(b, t, c).astype(jnp.float32) + b_r)
    gi = jax.nn.sigmoid(jnp.einsum('bthi,hij->bthj', xb, w_i).reshape(b, t, c).astype(jnp.float32) + b_i)
    log_a = LRU_C * r * jax.nn.log_sigmoid(lam.astype(jnp.float32))
    a = jnp.exp(log_a)
    inp = jnp.sqrt(-jnp.expm1(2.0 * log_a)) * (gi * x.astype(jnp.float32))

    def combine(left, right):
        a1, b1 = left
        a2, b2 = right
        return a1 * a2, a2 * b1 + b2

    _, h = lax.associative_scan(combine, (a, inp), axis=1)
    return h.astype(x.dtype)


def setup_inputs(seed: int = 0) -> dict:
    key = jax.random.key(seed)
    ks = jax.random.split(key, 24)
    f32 = jnp.float32
    nrm = lambda k, shape, scale: jax.random.normal(k, shape, f32) * scale
    u = jax.random.uniform(ks[10], (DEPTH, LRU_WIDTH), f32, 0.9, 0.999)
    a0 = u ** (1.0 / LRU_C)
    return {
        "x": nrm(ks[0], (BATCH, SEQ, D_MODEL), 1.0),
        "meta_tokens": nrm(ks[1], (N_META, D_MODEL), 1.0),
        "rel_bias_table": nrm(ks[2], (REL_BUCKETS, SWA_Q_HEADS), 0.5),
        "norm_mix": 1.0 + nrm(ks[3], (DEPTH, D_MODEL), 0.02),
        "w_in": nrm(ks[4], (DEPTH, D_MODEL, IN_COLS), D_MODEL ** -0.5),
        "swa_sinks": nrm(ks[5], (DEPTH, SWA_Q_HEADS), 0.5),
        "fox_forget_bias": 2.0 + 3.0 * jax.random.uniform(ks[6], (DEPTH, FOX_HEADS), f32),
        "conv_w": nrm(ks[7], (DEPTH, CONV_WIDTH, LRU_WIDTH), CONV_WIDTH ** -0.5),
        "conv_b": nrm(ks[8], (DEPTH, LRU_WIDTH), 0.02),
        "lru_w_r": nrm(ks[9], (DEPTH, LRU_BLOCKS, LRU_BLOCK_DIM, LRU_BLOCK_DIM), LRU_BLOCK_DIM ** -0.5),
        "lru_b_r": nrm(ks[11], (DEPTH, LRU_WIDTH), 0.02),
        "lru_w_i": nrm(ks[12], (DEPTH, LRU_BLOCKS, LRU_BLOCK_DIM, LRU_BLOCK_DIM), LRU_BLOCK_DIM ** -0.5),
        "lru_b_i": nrm(ks[13], (DEPTH, LRU_WIDTH), 0.02),
        "lru_lambda": jnp.log(a0) - jnp.log1p(-a0),
        "w_branch": nrm(ks[14], (DEPTH, N_BRANCH, LRU_WIDTH, D_MODEL), LRU_WIDTH ** -0.5),
        "w_out": nrm(ks[15], (DEPTH, D_MODEL, D_MODEL), D_MODEL ** -0.5),
        "norm_ffn": 1.0 + nrm(ks[16], (DEPTH, D_MODEL), 0.02),
        "w_ffn_in": nrm(ks[17], (DEPTH, D_MODEL, 2 * D_FF), D_MODEL ** -0.5),
        "w_ffn_out": nrm(ks[18], (DEPTH, D_FF, D_MODEL), D_FF ** -0.5),
        "norm_final": 1.0 + nrm(ks[19], (D_MODEL,), 0.02),
    }


def reference(x, meta_tokens, rel_bias_table, norm_mix, w_in, swa_sinks, fox_forget_bias, conv_w, conv_b,
              lru_w_r, lru_b_r, lru_w_i, lru_b_i, lru_lambda, w_branch, w_out, norm_ffn, w_ffn_in,
              w_ffn_out, norm_final):
    b = x.shape[0]
    meta = jnp.broadcast_to(meta_tokens.astype(x.dtype)[None], (b, N_META, D_MODEL))
    h = jnp.concatenate([meta, x], axis=1)
    t = h.shape[1]
    n_pad = (-t) % BLOCK
    split_points = [int(p) for p in np.cumsum(SPLIT_SIZES)[:-1]]
    for l in range(DEPTH):
        u = rms_norm(h, norm_mix[l])
        proj = u @ w_in[l]
        qa, ka, va, qf, kf, vf, fl, xc, yc, gates = jnp.split(proj, split_points, axis=-1)
        o_a = swa_sink_attention(
            pad_left(qa.reshape(b, t, SWA_Q_HEADS, HEAD_DIM), n_pad),
            pad_left(ka.reshape(b, t, SWA_KV_HEADS, HEAD_DIM), n_pad),
            pad_left(va.reshape(b, t, SWA_KV_HEADS, HEAD_DIM), n_pad),
            swa_sinks[l], rel_bias_table, n_pad)[:, n_pad:]
        log_f = jax.nn.log_sigmoid(fl.astype(jnp.float32) + fox_forget_bias[l].astype(jnp.float32))
        o_f = forgetting_attention(
            pad_left(qf.reshape(b, t, FOX_HEADS, HEAD_DIM), n_pad),
            pad_left(kf.reshape(b, t, FOX_HEADS, HEAD_DIM), n_pad),
            pad_left(vf.reshape(b, t, FOX_HEADS, HEAD_DIM), n_pad),
            pad_left(log_f, n_pad), n_pad)[:, n_pad:]
        xc = causal_depthwise_conv(xc, conv_w[l], conv_b[l])
        o_c = rg_lru(xc, lru_w_r[l], lru_b_r[l], lru_w_i[l], lru_b_i[l], lru_lambda[l]) * jax.nn.gelu(yc)
        g = jax.nn.sigmoid(gates).reshape(b, t, N_BRANCH, D_MODEL)
        merged = (g[:, :, 0] * (o_a @ w_branch[l, 0])
                  + g[:, :, 1] * (o_f @ w_branch[l, 1])
                  + g[:, :, 2] * (o_c @ w_branch[l, 2]))
        h = h + merged @ w_out[l]
        u = rms_norm(h, norm_ffn[l])
        gate_ff, up_ff = jnp.split(u @ w_ffn_in[l], 2, axis=-1)
        h = h + (jax.nn.silu(gate_ff) * up_ff) @ w_ffn_out[l]
    return rms_norm(h, norm_final)[:, N_META:]
```

```cpp
#include <hip/hip_runtime.h>
#include <hip/hip_cooperative_groups.h>
#include <cstdio>
#include <cstdint>
namespace pg8 {
#define PG8_LAS __attribute__((address_space(3)))
typedef unsigned short bf16_t;
typedef short bf16x8 __attribute__((ext_vector_type(8)));
typedef float f32x4 __attribute__((ext_vector_type(4)));
typedef unsigned u32x4 __attribute__((ext_vector_type(4)));
constexpr int BM = 256, BK = 64, HALF = 128, HTB = HALF * BK * 2  , STAGE_BYTES = 8 * HTB, NXCD = 8, WGM = 8;

__host__ __device__ __forceinline__ int lds_byte(int r, int c) { const int st = (r >> 4) * 2 + (c >> 5), rr = r & 15, cc = c & 31, ob = rr * 64 + cc * 2; return st * 1024 + (ob ^ (((ob >> 9) & 1) << 5)); }
__host__ __device__ __forceinline__ void stage_rc(int b, int& R, int& C) { const int st = b / 1024, sb = b % 1024, swz = sb ^ (((sb >> 9) & 1) << 5); R = (st >> 1) * 16 + swz / 64; C = (st & 1) * 32 + (swz % 64) / 2; }
__host__ __device__ __forceinline__ int perm32(int rho) { const int n = rho >> 4, i = rho & 15; return 8 * (i >> 2) + 4 * n + (i & 3); }

struct Unit { int pm, pn, g; };
struct Gemm { const bf16_t* A; const bf16_t* Bt; };

template <int nM, int nN, int NG> struct Order {
    static constexpr int nwg = nM * nN;
    int G, c;
    __device__ void init(int G_, int c_) { G = G_; c = c_; }
    __device__ bool next(int i, Unit& u) const {
        const int ti = (NG == 1) ? i : i / NG; u.g = (NG == 1) ? 0 : i - ti * NG;
        const long L = (long)ti * G + c; if (L >= nwg) return false;
        int wgid = (int)L; { constexpr int q = nwg / NXCD, r = nwg % NXCD; const int xcd = wgid % NXCD, off = wgid / NXCD; wgid = (xcd < r ? xcd * (q + 1) : r * (q + 1) + (xcd - r) * q) + off; }
        constexpr int nig = WGM * nN; const int gid = wgid / nig, fm = gid * WGM, gsz = (nM - fm) < WGM ? (nM - fm) : WGM;
        u.pm = fm + ((wgid % nig) % gsz); u.pn = (wgid % nig) / gsz; return true;
    }
    __device__ __forceinline__ void a_ready(const Unit&) const {}
    __device__ __forceinline__ void done(const Unit&) const {}
};
__device__ __forceinline__ unsigned cvt_pk_bf16(float lo, float hi) { unsigned r; asm volatile("v_cvt_pk_bf16_f32 %0, %1, %2" : "=v"(r) : "v"(lo), "v"(hi)); return r; }
__device__ __forceinline__ float bf_lo(unsigned w) { return __uint_as_float(w << 16); }
__device__ __forceinline__ float bf_hi(unsigned w) { return __uint_as_float(w & 0xffff0000u); }
__device__ __forceinline__ float sigmoid_f(float x) { return __builtin_amdgcn_rcpf(1.f + __expf(-x)); }
constexpr int M_TOK = 32896, T_TOK = 4112, NPROJ = 6656, GATE_OFF = 3328, DFF = 2816, DM = 1024;

struct EpiProj {
    static constexpr bool PERM = true, AFTER_DRAIN = false;
    bf16_t* P; float* fl; const unsigned long long* ssq; int grow0;
    __device__ __forceinline__ void operator()(const f32x4 (&acc)[2][2][4][2], const Unit& u, int wr, int wc, int fr, int fq) const {
        const int row0 = u.pm * BM + wr * 64 + fr, col0 = u.pn * BM + wc * 32 + 8 * fq;
#pragma unroll
        for (int ai = 0; ai < 2; ++ai)
#pragma unroll
            for (int m = 0; m < 4; ++m) { const int lrow = row0 + ai * HALF + m * 16, grow = lrow + grow0;
                const float s = (grow < M_TOK) ? rsqrtf((float)ssq[grow] * (1.0f / (1024.0f * 1048576.0f)) + 1e-6f) : 0.f;
                if (u.pn < 25) {
#pragma unroll
                    for (int bj = 0; bj < 2; ++bj) { const f32x4 v0 = acc[ai][bj][m][0] * s, v1 = acc[ai][bj][m][1] * s;
                        u32x4 w; w.x = cvt_pk_bf16(v0[0], v0[1]); w.y = cvt_pk_bf16(v0[2], v0[3]); w.z = cvt_pk_bf16(v1[0], v1[1]); w.w = cvt_pk_bf16(v1[2], v1[3]);
                        *(u32x4*)(P + (size_t)lrow * NPROJ + col0 + bj * HALF) = w; }
                } else if (wc == 0 && fq == 0) {
                    *(f32x4*)(fl + (size_t)lrow * 8) = acc[ai][0][m][0] * s; *(f32x4*)(fl + (size_t)lrow * 8 + 4) = acc[ai][0][m][1] * s; }
            }
    }
};
struct EpiBranch {
    static constexpr bool PERM = true, AFTER_DRAIN = false;
    const bf16_t* P; bf16_t* MG;
    __device__ __forceinline__ void operator()(const f32x4 (&acc)[2][2][4][2], const Unit& u, int wr, int wc, int fr, int fq) const {
        const int row0 = u.pm * BM + wr * 64 + fr, col0 = u.pn * BM + wc * 32 + 8 * fq;
#pragma unroll
        for (int ai = 0; ai < 2; ++ai)
#pragma unroll
            for (int m = 0; m < 4; ++m) { const int lrow = row0 + ai * HALF + m * 16;
#pragma unroll
                for (int bj = 0; bj < 2; ++bj) { const int c = col0 + bj * HALF;
                    const u32x4 gw = *(const u32x4*)(P + (size_t)lrow * NPROJ + GATE_OFF + u.g * DM + c);
                    f32x4 v0 = acc[ai][bj][m][0], v1 = acc[ai][bj][m][1];
                    v0[0] *= sigmoid_f(bf_lo(gw.x)); v0[1] *= sigmoid_f(bf_hi(gw.x)); v0[2] *= sigmoid_f(bf_lo(gw.y)); v0[3] *= sigmoid_f(bf_hi(gw.y));
                    v1[0] *= sigmoid_f(bf_lo(gw.z)); v1[1] *= sigmoid_f(bf_hi(gw.z)); v1[2] *= sigmoid_f(bf_lo(gw.w)); v1[3] *= sigmoid_f(bf_hi(gw.w));
                    bf16_t* mp = MG + (size_t)lrow * DM + c;
                    if (u.g > 0) { const u32x4 pw = *(const u32x4*)mp;
                        v0[0] += bf_lo(pw.x); v0[1] += bf_hi(pw.x); v0[2] += bf_lo(pw.y); v0[3] += bf_hi(pw.y); v1[0] += bf_lo(pw.z); v1[1] += bf_hi(pw.z); v1[2] += bf_lo(pw.w); v1[3] += bf_hi(pw.w); }
                    u32x4 w; w.x = cvt_pk_bf16(v0[0], v0[1]); w.y = cvt_pk_bf16(v0[2], v0[3]); w.z = cvt_pk_bf16(v1[0], v1[1]); w.w = cvt_pk_bf16(v1[2], v1[3]);
                    *(u32x4*)mp = w; }
            }
    }
};
struct EpiRes {
    static constexpr bool PERM = false, AFTER_DRAIN = false;
    float* hout; float* hmeta; bf16_t* hb; unsigned long long* ssq;
    __device__ __forceinline__ void operator()(const f32x4 (&acc)[2][2][4][2], const Unit& u, int wr, int wc, int fr, int fq) const {
        typedef unsigned u32x2v __attribute__((ext_vector_type(2)));
        const int row0 = u.pm * BM + wr * 64 + fr, col0 = u.pn * BM + wc * 32 + 4 * fq;
#pragma unroll
        for (int ai = 0; ai < 2; ++ai)
#pragma unroll
            for (int m = 0; m < 4; ++m) { const int grow = row0 + ai * HALF + m * 16; float ss = 0.f;
                if (grow < M_TOK) { const int b = grow / T_TOK, t = grow - b * T_TOK;
                    float* hp = (t < 16) ? hmeta + (size_t)(b * 16 + t) * DM : hout + ((size_t)b * 4096 + (t - 16)) * DM;
#pragma unroll
                    for (int bj = 0; bj < 2; ++bj)
#pragma unroll
                        for (int n = 0; n < 2; ++n) { const int c = col0 + bj * HALF + n * 16;
                            const f32x4 o = *(const f32x4*)(hp + c) + acc[ai][bj][m][n]; *(f32x4*)(hp + c) = o;
                            ss += (o[0] * o[0] + o[1] * o[1]) + (o[2] * o[2] + o[3] * o[3]);
                            u32x2v w; w.x = cvt_pk_bf16(o[0], o[1]); w.y = cvt_pk_bf16(o[2], o[3]); *(u32x2v*)(hb + (size_t)grow * DM + c) = w; } }
                ss += __shfl_xor(ss, 16); ss += __shfl_xor(ss, 32);
                if (fq == 0 && grow < M_TOK) atomicAdd(ssq + grow, (unsigned long long)(ss * 1048576.0f));
            }
    }
};
struct EpiSwiglu {
    static constexpr bool PERM = true, AFTER_DRAIN = false;
    bf16_t* ACT; const unsigned long long* ssq;
    __device__ __forceinline__ void operator()(const f32x4 (&acc)[2][2][4][2], const Unit& u, int wr, int wc, int fr, int fq) const {
        const int row0 = u.pm * BM + wr * 64 + fr, col0 = u.pn * HALF + wc * 32 + 8 * fq;
#pragma unroll
        for (int ai = 0; ai < 2; ++ai)
#pragma unroll
            for (int m = 0; m < 4; ++m) { const int grow = row0 + ai * HALF + m * 16;
                const float s = (grow < M_TOK) ? rsqrtf((float)ssq[grow] * (1.0f / (1024.0f * 1048576.0f)) + 1e-6f) : 0.f;
                float o[8];
#pragma unroll
                for (int n = 0; n < 2; ++n)
#pragma unroll
                    for (int j = 0; j < 4; ++j) { const float gt = acc[ai][0][m][n][j] * s, up = acc[ai][1][m][n][j] * s; o[4 * n + j] = gt * sigmoid_f(gt) * up; }
                u32x4 w; w.x = cvt_pk_bf16(o[0], o[1]); w.y = cvt_pk_bf16(o[2], o[3]); w.z = cvt_pk_bf16(o[4], o[5]); w.w = cvt_pk_bf16(o[6], o[7]);
                *(u32x4*)(ACT + (size_t)grow * DFF + col0) = w; }
    }
};

template <class Epi, class Sched, bool ALIGN_EPI, bool SP2, int GK, int LDA, int AGOFF, int BGT>
__device__ __forceinline__ void gemm_phase(PG8_LAS unsigned char* lds, const Gemm g, const Sched& S, const Epi& E) {
    const int tid = threadIdx.x, wid = __builtin_amdgcn_readfirstlane(tid >> 6), lane = tid & 63, wr = wid >> 2, wc = wid & 3, fr = lane & 15, fq = lane >> 4;
    constexpr int K = GK, nt = K / BK;
    unsigned voffA[2], voffB[2];
#pragma unroll
    for (int i = 0; i < 2; ++i) { int R, C; stage_rc(tid * 16 + i * 8192, R, C); const int Rb = Epi::PERM ? ((R & ~31) + perm32(R & 31)) : R;
        voffA[i] = (unsigned)(R * LDA + C) * 2u; voffB[i] = (unsigned)(Rb * K + C) * 2u; }
    constexpr size_t kstep = (size_t)(BK * 2);
    constexpr size_t hstepA = (size_t)HALF * LDA * 2, hstepB = (size_t)HALF * K * 2;
    constexpr size_t tstepA = 2 * hstepA, tstepB = 2 * hstepB;
    const unsigned ldsw = (unsigned)wid * 1024u;
    const int aoff = lds_byte(wr * 64 + fr, fq * 8), boff = lds_byte(wc * 32 + fr, fq * 8);
#define PG8_SA(b, h) (((b) * 2 + (h)) * HTB)
#define PG8_SB(b, h) ((4 + (b) * 2 + (h)) * HTB)
#define PG8_STAGE(bufoff, gbase, voff) do { _Pragma("unroll") for (int _i = 0; _i < 2; ++_i) \
        __builtin_amdgcn_global_load_lds((const unsigned*)((const char*)(gbase) + (voff)[_i]), (PG8_LAS unsigned*)(lds + (bufoff) + ldsw + _i * 8192), 16, 0, 0); } while (0)
#define PG8_LDA(dst, b, h) do { _Pragma("unroll") for (int m = 0; m < 4; ++m) _Pragma("unroll") for (int k = 0; k < 2; ++k) dst[m][k] = *(const PG8_LAS bf16x8*)(lds + PG8_SA(b, h) + aoff + m * 2048 + k * 1024); } while (0)
#define PG8_LDB(dst, b, h) do { _Pragma("unroll") for (int n = 0; n < 2; ++n) _Pragma("unroll") for (int k = 0; k < 2; ++k) dst[n][k] = *(const PG8_LAS bf16x8*)(lds + PG8_SB(b, h) + boff + n * 2048 + k * 1024); } while (0)
#define PG8_MMA(ai, bj, At, Bt) do { __builtin_amdgcn_s_setprio(1); _Pragma("unroll") for (int m = 0; m < 4; ++m) _Pragma("unroll") for (int n = 0; n < 2; ++n) _Pragma("unroll") for (int k = 0; k < 2; ++k) \
        acc[ai][bj][m][n] = __builtin_amdgcn_mfma_f32_16x16x32_bf16(Bt[n][k], At[m][k], acc[ai][bj][m][n], 0, 0, 0); __builtin_amdgcn_s_setprio(0); } while (0)
#define PG8_WAIT_V(n) asm volatile("s_waitcnt vmcnt(" #n ")" ::: "memory")
#define PG8_WAIT_L(n) asm volatile("s_waitcnt lgkmcnt(" #n ")" ::: "memory")
#define PG8_BAR __builtin_amdgcn_s_barrier()
#define PG8_SCHED __builtin_amdgcn_sched_barrier(0)
    Unit cur, nxt; int ui = 0;
    if (!S.next(0, cur)) return;
    f32x4 acc[2][2][4][2];
#pragma unroll
    for (int a = 0; a < 2; ++a)
#pragma unroll
        for (int b = 0; b < 2; ++b)
#pragma unroll
            for (int m = 0; m < 4; ++m)
#pragma unroll
                for (int n = 0; n < 2; ++n) acc[a][b][m][n] = (f32x4){0.f, 0.f, 0.f, 0.f};
    bf16x8 At[4][2], B0[2][2], B1[2][2];
    const char* cA = (const char*)g.A + (size_t)cur.pm * tstepA + (size_t)cur.g * AGOFF * 2; const char* cB = (const char*)g.Bt + (size_t)(cur.pn + cur.g * BGT) * tstepB;
    S.a_ready(cur);
    if constexpr (SP2) {
        PG8_STAGE(PG8_SB(0, 0), cB, voffB); PG8_STAGE(PG8_SB(0, 1), cB + hstepB, voffB); PG8_STAGE(PG8_SA(0, 0), cA, voffA); PG8_STAGE(PG8_SA(0, 1), cA + hstepA, voffA);
        if (wr == 1) PG8_BAR;
        PG8_WAIT_V(2); PG8_BAR;
        PG8_STAGE(PG8_SB(1, 0), cB + kstep, voffB); PG8_STAGE(PG8_SA(1, 0), cA + kstep, voffA); PG8_STAGE(PG8_SB(1, 1), cB + hstepB + kstep, voffB);
        PG8_WAIT_V(6); PG8_BAR;
    } else {
        PG8_STAGE(PG8_SB(0, 0), cB, voffB); PG8_STAGE(PG8_SA(0, 0), cA, voffA); PG8_STAGE(PG8_SB(0, 1), cB + hstepB, voffB); PG8_STAGE(PG8_SA(0, 1), cA + hstepA, voffA);
        if (wr == 1) PG8_BAR;
        PG8_WAIT_V(4); PG8_BAR;
        PG8_STAGE(PG8_SB(1, 0), cB + kstep, voffB); PG8_STAGE(PG8_SA(1, 0), cA + kstep, voffA); PG8_STAGE(PG8_SB(1, 1), cB + hstepB + kstep, voffB);
        PG8_WAIT_V(6); PG8_BAR;
    }
    for (;;) {
        const bool has_next = S.next(ui + 1, nxt);
        const char* nA = has_next ? (const char*)g.A + (size_t)nxt.pm * tstepA + (size_t)nxt.g * AGOFF * 2 : cA; const char* nB = has_next ? (const char*)g.Bt + (size_t)(nxt.pn + nxt.g * BGT) * tstepB : cB;
        for (int t = 0; t < nt; t += 2) {
            const bool last = (t == nt - 2);
            const char* a1 = cA + (size_t)(t + 1) * kstep;
            const char* a2 = last ? nA : cA + (size_t)(t + 2) * kstep; const char* b2 = last ? nB : cB + (size_t)(t + 2) * kstep;
            const char* a3 = a2 + kstep; const char* b3 = b2 + kstep;
            if (last && has_next) S.a_ready(nxt);
            if constexpr (SP2) {
            PG8_LDB(B0, 0, 0); PG8_LDB(B1, 0, 1); PG8_SCHED; PG8_LDA(At, 0, 0); PG8_STAGE(PG8_SA(1, 1), a1 + hstepA, voffA);
            PG8_WAIT_V(8); PG8_WAIT_L(0); PG8_BAR; PG8_MMA(0, 0, At, B0); PG8_MMA(0, 1, At, B1); PG8_BAR; PG8_SCHED;
            PG8_LDA(At, 0, 1); PG8_STAGE(PG8_SB(0, 0), b2, voffB); PG8_STAGE(PG8_SB(0, 1), b2 + hstepB, voffB); PG8_STAGE(PG8_SA(0, 0), a2, voffA);
            PG8_WAIT_V(8); PG8_WAIT_L(0); PG8_BAR; PG8_MMA(1, 0, At, B0); PG8_MMA(1, 1, At, B1); PG8_BAR; PG8_SCHED;
            PG8_LDB(B0, 1, 0); PG8_LDB(B1, 1, 1); PG8_SCHED; PG8_LDA(At, 1, 0); PG8_STAGE(PG8_SA(0, 1), a2 + hstepA, voffA);
            PG8_WAIT_V(8); PG8_WAIT_L(0); PG8_BAR; PG8_MMA(0, 0, At, B0); PG8_MMA(0, 1, At, B1); PG8_BAR; PG8_SCHED;
            PG8_LDA(At, 1, 1); PG8_STAGE(PG8_SB(1, 0), b3, voffB); PG8_STAGE(PG8_SB(1, 1), b3 + hstepB, voffB); PG8_STAGE(PG8_SA(1, 0), a3, voffA);
            PG8_WAIT_V(8); PG8_WAIT_L(0); PG8_BAR; PG8_MMA(1, 0, At, B0); PG8_MMA(1, 1, At, B1); PG8_BAR; PG8_SCHED;
            } else {
            PG8_LDB(B0, 0, 0); PG8_SCHED; PG8_LDA(At, 0, 0); PG8_STAGE(PG8_SA(1, 1), a1 + hstepA, voffA);
            PG8_WAIT_L(8); PG8_BAR; PG8_WAIT_L(0); PG8_MMA(0, 0, At, B0); PG8_BAR; PG8_SCHED;
            PG8_LDB(B1, 0, 1); PG8_STAGE(PG8_SB(0, 0), b2, voffB);
            PG8_BAR; PG8_WAIT_L(0); PG8_MMA(0, 1, At, B1); PG8_BAR;
            PG8_LDA(At, 0, 1); PG8_STAGE(PG8_SA(0, 0), a2, voffA);
            PG8_BAR; PG8_WAIT_L(0); PG8_MMA(1, 0, At, B0); PG8_BAR; PG8_SCHED;
            PG8_STAGE(PG8_SB(0, 1), b2 + hstepB, voffB);
            PG8_WAIT_V(6); PG8_BAR; PG8_MMA(1, 1, At, B1); PG8_BAR;
            PG8_LDB(B0, 1, 0); PG8_SCHED; PG8_LDA(At, 1, 0); PG8_STAGE(PG8_SA(0, 1), a2 + hstepA, voffA);
            PG8_WAIT_L(8); PG8_BAR; PG8_WAIT_L(0); PG8_MMA(0, 0, At, B0); PG8_BAR; PG8_SCHED;
            PG8_LDB(B1, 1, 1); PG8_STAGE(PG8_SB(1, 0), b3, voffB);
            PG8_BAR; PG8_WAIT_L(0); PG8_MMA(0, 1, At, B1); PG8_BAR;
            PG8_LDA(At, 1, 1); PG8_STAGE(PG8_SA(1, 0), a3, voffA);
            PG8_BAR; PG8_WAIT_L(0); PG8_MMA(1, 0, At, B0); PG8_BAR; PG8_SCHED;
            PG8_STAGE(PG8_SB(1, 1), b3 + hstepB, voffB);
            PG8_WAIT_V(6); PG8_BAR; PG8_MMA(1, 1, At, B1); PG8_BAR;
            }
        }
        if constexpr (ALIGN_EPI) { if (wr == 0) PG8_BAR; }
        if constexpr (!Epi::AFTER_DRAIN) { E(acc, cur, wr, wc, fr, fq); S.done(cur); }
        if (!has_next) break;
#pragma unroll
        for (int a = 0; a < 2; ++a)
#pragma unroll
            for (int b = 0; b < 2; ++b)
#pragma unroll
                for (int m = 0; m < 4; ++m)
#pragma unroll
                    for (int n = 0; n < 2; ++n) acc[a][b][m][n] = (f32x4){0.f, 0.f, 0.f, 0.f};
        cur = nxt; cA = nA; cB = nB; ++ui;
        if constexpr (ALIGN_EPI) { if (wr == 1) PG8_BAR; }
    }
    PG8_WAIT_V(0);
    if constexpr (!ALIGN_EPI) { if (wr == 0) PG8_BAR; }
    PG8_BAR;
    if constexpr (Epi::AFTER_DRAIN) { E.fused(acc, cur, wr, wc, fr, fq, lds, wid, lane); S.done(cur); }
#undef PG8_SA
#undef PG8_SB
#undef PG8_STAGE
#undef PG8_LDA
#undef PG8_LDB
#undef PG8_MMA
#undef PG8_WAIT_V
#undef PG8_WAIT_L
#undef PG8_BAR
#undef PG8_SCHED
}
}

#include <hip/hip_bf16.h>
#include <cmath>
namespace attn_body {
using bf16=__hip_bfloat16;
using bf16x8=__attribute__((ext_vector_type(8)))short;
using s16x4=__attribute__((ext_vector_type(4)))short;
using f32x16=__attribute__((ext_vector_type(16)))float;
using u32x4=__attribute__((ext_vector_type(4)))unsigned;
constexpr int D=64,PQ=6656,PO=1536,TTOK=4112;
constexpr int NW=8,QBLK=32,QB=QBLK*NW,KVBLK=64,NQB=17;
__device__ __forceinline__ int crow(int r,int hi){return (r&3)+8*(r>>2)+4*hi;}
#define SBAR() __builtin_amdgcn_sched_barrier(0)
__device__ __forceinline__ void cmask(f32x16&p0,f32x16&p1,int jb,int qrel,int hi){
  const float NEG=-INFINITY; int kb=64*jb+4*hi;
  #pragma unroll
  for(int r=0;r<16;++r){int kv=kb+(r&3)+8*(r>>2); if(kv>qrel)p0[r]=NEG; if(kv+32>qrel)p1[r]=NEG;}
}

constexpr int NSLOT=3, SLOTB=8192;
constexpr int LDS_K=0, LDS_V=NSLOT*SLOTB, LDS_WS=2*NSLOT*SLOTB, LDS_OST=LDS_WS+NW*64*4, LDS_BYTES=LDS_OST+NW*4096, LDS_DK=LDS_BYTES, LDS_END=LDS_DK+66*256;
constexpr float C2=0.125f*1.4426950408889634f;
__device__ __forceinline__ void glds16(const void*gsrc,unsigned lds_dst){unsigned keep;
  asm volatile("s_mov_b32 %0, m0\n\ts_mov_b32 m0, %2\n\ts_nop 0\n\tglobal_load_lds_dwordx4 %1, off\n\ts_mov_b32 m0, %0":"=&s"(keep):"v"(gsrc),"s"(lds_dst):"memory");}
__device__ __forceinline__ float max3f(float a,float b,float c){float r;asm("v_max3_f32 %0, %1, %2, %3":"=v"(r):"v"(a),"v"(b),"v"(c));return r;}
__device__ __forceinline__ float max2f(float a,float b){float r;asm("v_max_f32_e32 %0, %1, %2":"=v"(r):"v"(a),"v"(b));return r;}
__device__ __forceinline__ float fadd_s(float a,float b){float r;asm("v_add_f32_e32 %0, %1, %2":"=v"(r):"v"(a),"v"(b));return r;}
__device__ __forceinline__ float fsub_s(float a,float b){float r;asm("v_sub_f32_e32 %0, %1, %2":"=v"(r):"v"(a),"v"(b));return r;}
typedef float f32x2_t __attribute__((ext_vector_type(2))); typedef __bf16 bf16x2_t __attribute__((ext_vector_type(2)));
__device__ __forceinline__ unsigned cvtpk_s(float lo,float hi){f32x2_t v={lo,hi};bf16x2_t b=__builtin_convertvector(v,bf16x2_t);return __builtin_bit_cast(unsigned,b);}
#define WAIT_BAR(N) asm volatile("s_waitcnt vmcnt(" #N ") lgkmcnt(0)\n\ts_barrier":::"memory")

__device__ __forceinline__ void qkt(f32x16&p0,f32x16&p1,const char*Kslot,const bf16x8*qr,const f32x16&negm,int r32,int hi){
  const char*kb=Kslot+hi*1024+r32*16;
  #pragma unroll
  for(int d0=0;d0<4;++d0){
    const bf16x8 b0=*reinterpret_cast<const bf16x8*>(kb+d0*2048);
    const bf16x8 b1=*reinterpret_cast<const bf16x8*>(kb+d0*2048+512);
    if(d0==0){p0=__builtin_amdgcn_mfma_f32_32x32x16_bf16(b0,qr[0],negm,0,0,0);p1=__builtin_amdgcn_mfma_f32_32x32x16_bf16(b1,qr[0],negm,0,0,0);}
    else{p0=__builtin_amdgcn_mfma_f32_32x32x16_bf16(b0,qr[d0],p0,0,0,0);p1=__builtin_amdgcn_mfma_f32_32x32x16_bf16(b1,qr[d0],p1,0,0,0);}}
}
typedef __attribute__((address_space(3))) const char* lds_cptr;
typedef short v4i16_t __attribute__((ext_vector_type(4)));
__device__ __forceinline__ void kload8(bf16x8*kf,lds_cptr kp){
  kf[0]=*(const __attribute__((address_space(3))) bf16x8*)(kp);      kf[1]=*(const __attribute__((address_space(3))) bf16x8*)(kp+512);
  kf[2]=*(const __attribute__((address_space(3))) bf16x8*)(kp+2048); kf[3]=*(const __attribute__((address_space(3))) bf16x8*)(kp+2560);
  kf[4]=*(const __attribute__((address_space(3))) bf16x8*)(kp+4096); kf[5]=*(const __attribute__((address_space(3))) bf16x8*)(kp+4608);
  kf[6]=*(const __attribute__((address_space(3))) bf16x8*)(kp+6144); kf[7]=*(const __attribute__((address_space(3))) bf16x8*)(kp+6656);
}
__device__ __forceinline__ void kload2(bf16x8*kf,lds_cptr kp,int j){ kf[2*j]=*(const __attribute__((address_space(3))) bf16x8*)(kp+j*2048); kf[2*j+1]=*(const __attribute__((address_space(3))) bf16x8*)(kp+j*2048+512); }
__device__ __forceinline__ s16x4 vtr(lds_cptr p){ return __builtin_bit_cast(s16x4,__builtin_amdgcn_ds_read_tr16_b64_v4i16((__attribute__((address_space(3))) v4i16_t*)p)); }
__device__ __forceinline__ float rowmax(const f32x16&p0,const f32x16&p1){
  float a=max3f(p0[0],p0[1],p1[0]),b=max3f(p0[2],p0[3],p1[1]);a=max3f(a,p1[2],p1[3]);
  #pragma unroll
  for(int r=4;r<16;r+=4){a=max3f(a,p0[r],p0[r+1]);b=max3f(b,p0[r+2],p0[r+3]);a=max3f(a,p1[r],p1[r+1]);b=max3f(b,p1[r+2],p1[r+3]);}
  const float m=max2f(a,b);
  auto rr=__builtin_amdgcn_permlane32_swap(__float_as_uint(m),__float_as_uint(m),false,false);
  return max2f(__uint_as_float(rr[0]),__uint_as_float(rr[1]));
}
__device__ __forceinline__ void pv(f32x16*o,int vb,bf16x8 pa0,bf16x8 pa1,bf16x8 pa2,bf16x8 pa3){
  #pragma unroll
  for(int d0=0;d0<2;++d0){s16x4 lo[4],hi[4];
    #pragma unroll
    for(int ks=0;ks<4;++ks){
      asm volatile("ds_read_b64_tr_b16 %0,%1 offset:%c2":"=&v"(lo[ks]):"v"(vb),"i"(d0*4096+ks*1024):"memory");
      asm volatile("ds_read_b64_tr_b16 %0,%1 offset:%c2":"=&v"(hi[ks]):"v"(vb),"i"(d0*4096+ks*1024+512):"memory");}
    asm volatile("s_waitcnt lgkmcnt(0)":::"memory");SBAR();
    #define PK(k) (bf16x8){lo[k][0],lo[k][1],lo[k][2],lo[k][3],hi[k][0],hi[k][1],hi[k][2],hi[k][3]}
    o[d0]=__builtin_amdgcn_mfma_f32_32x32x16_bf16(pa0,PK(0),o[d0],0,0,0);
    o[d0]=__builtin_amdgcn_mfma_f32_32x32x16_bf16(pa1,PK(1),o[d0],0,0,0);
    o[d0]=__builtin_amdgcn_mfma_f32_32x32x16_bf16(pa2,PK(2),o[d0],0,0,0);
    o[d0]=__builtin_amdgcn_mfma_f32_32x32x16_bf16(pa3,PK(3),o[d0],0,0,0);
    #undef PK
  }
}

#ifndef ATTN_STORE16
#define ATTN_STORE16(p,v) (*(u32x4*)(p)=(v))
#endif
template<int THRL> __device__ __forceinline__ void attn_unit(int b,int h,int qb,const bf16*Q,const bf16*__restrict__ K,const bf16*__restrict__ V,bf16*O,const float*__restrict__ dkg,char*shm){
  const int tid=threadIdx.x,lane=tid&63,r32=lane&31,hi=lane>>5; const int wid=__builtin_amdgcn_readfirstlane(tid>>6);
  const long rowbase=(long)b*TTOK; const int q0=qb*QB;
  const bf16*Qw=Q+(rowbase+q0+wid*QBLK)*PQ+h*D;
  const bf16*Kh=K+rowbase*PQ+h*D,*Vh=V+rowbase*PQ+h*D;
  const unsigned lds0=(unsigned)(uintptr_t)shm;
  float*wsf=(float*)(shm+LDS_WS)+wid*64;
  const bf16*ksrc=Kh+(long)lane*PQ+wid*8;
  const bf16*vsrc=Vh+(long)(16*(wid&3)+(lane>>2))*PQ+(wid>>2)*32+(lane&3)*8;
  const unsigned kdst=lds0+LDS_K+wid*1024, vdst=lds0+LDS_V+wid*1024;
  #define DMA_K(t,slot) glds16(ksrc+(long)(t)*KVBLK*PQ,(unsigned)__builtin_amdgcn_readfirstlane(kdst+(slot)))
  #define DMA_V(t,slot) glds16(vsrc+(long)(t)*KVBLK*PQ,(unsigned)__builtin_amdgcn_readfirstlane(vdst+(slot)))
  const int vb0=(int)(lds0+LDS_V)+((lane>>4)&1)*32+(lane&3)*8+(4*hi+((lane&15)>>2))*64;
  const char*Kbase=shm+LDS_K; bf16x8 kf[8];
  const lds_cptr shm3=(lds_cptr)shm; const lds_cptr kp0=shm3+LDS_K+hi*1024+r32*16; const lds_cptr vp0=shm3+LDS_V+((lane>>4)&1)*32+(lane&3)*8+(4*hi+((lane&15)>>2))*64;
  const int NT=(qb==NQB-1)?66:(q0+QB)/KVBLK; const int band0=4*qb;
  { typedef float f4_t __attribute__((ext_vector_type(4)));
    for(int i_=tid;i_<NT*16;i_+=NW*64){ const f4_t v_=*(const f4_t*)(dkg+4*i_); *(__attribute__((address_space(3))) f4_t*)(shm3+LDS_DK+16*i_)=v_; } }
  #define ADDK(P0,P1,t) do{ typedef float f4_t __attribute__((ext_vector_type(4))); const __attribute__((address_space(3))) f4_t* dq_=(const __attribute__((address_space(3))) f4_t*)(shm3+LDS_DK+(t)*256+hi*16); \
    _Pragma("unroll") for(int g_=0;g_<4;++g_){ const f4_t a_=dq_[2*g_]-mhat, b_=dq_[8+2*g_]-mhat; \
      P0[4*g_]+=a_[0];P0[4*g_+1]+=a_[1];P0[4*g_+2]+=a_[2];P0[4*g_+3]+=a_[3]; P1[4*g_]+=b_[0];P1[4*g_+1]+=b_[1];P1[4*g_+2]+=b_[2];P1[4*g_+3]+=b_[3]; } }while(0)
  DMA_K(0,0);DMA_V(0,0);DMA_K(1,SLOTB);
  bf16x8 qr[4];
  #pragma unroll
  for(int d0=0;d0<4;++d0)qr[d0]=*reinterpret_cast<const bf16x8*>(&Qw[(long)r32*PQ+d0*16+hi*8]);
  float mhat=0.f,l_reg=0.f;f32x16 o[2];o[0]=f32x16{};o[1]=f32x16{};
  const int qrel=wid*QBLK+r32;
  #define CMASK(P0,P1,t) do{int jb_=(t)-band0; if(jb_>=0)cmask(P0,P1,jb_,qrel,hi);}while(0)
  bool resc=false;
  #define START(P0,P1) do{ const float rm=rowmax(P0,P1); resc=false; \
    { const float dl=rm; mhat=fadd_s(mhat,dl); \
      _Pragma("unroll") for(int r=0;r<16;++r){P0[r]=fsub_s(P0[r],dl);P1[r]=fsub_s(P1[r],dl);} \
       } \
    _Pragma("unroll") for(int r=0;r<16;++r)P0[r]=__builtin_amdgcn_exp2f(P0[r]); }while(0)
  #define RESC() do{ if(resc){ asm volatile("s_waitcnt lgkmcnt(0)":::"memory"); \
      _Pragma("unroll") for(int d_=0;d_<2;++d_) _Pragma("unroll") for(int r=0;r<16;++r)o[d_][r]*=wsf[crow(r,hi)]; } }while(0)
  f32x16 pA0,pA1,pB0,pB1;
  int sl_prev=0,sl_cur=0,sl_next=SLOTB;
  #define ROT() do{sl_prev=sl_cur;sl_cur=sl_next;sl_next=(sl_next==(NSLOT-1)*SLOTB)?0:sl_next+SLOTB;}while(0)
  DMA_K(2,2*SLOTB);
  WAIT_BAR(3);
  { const f32x16 zc_=f32x16{}; qkt(pA0,pA1,Kbase,qr,zc_,r32,hi); }asm volatile("s_nop 15\n\ts_nop 7":"+v"(pA0),"+v"(pA1));ADDK(pA0,pA1,0);CMASK(pA0,pA1,0);
  START(pA0,pA1);
  _Pragma("unroll") for(int r=0;r<16;++r)pA1[r]=__builtin_amdgcn_exp2f(pA1[r]);
  WAIT_BAR(0);
  DMA_K(3,0);DMA_V(1,SLOTB);
  ROT();
  kload8(kf,kp0+sl_cur);
  WAIT_BAR(2);
  s16x4 vlo[8],vhi[8]; u32x4 pw0,pw1,pw2,pw3;
  #define PKW(P,B) cvtpk_s(P[B],P[B+1])
  #define PAF(k) __builtin_bit_cast(bf16x8,pw##k)
  #define VFR(i) (bf16x8){vlo[i][0],vlo[i][1],vlo[i][2],vlo[i][3],vhi[i][0],vhi[i][1],vhi[i][2],vhi[i][3]}
  #define PIN(x) asm volatile("":"+v"(x))
  #define MX3(a,b,c) __builtin_fmaxf(__builtin_fmaxf((a),(b)),(c))
  #define GAPA(MF,A0,A1,A2,A3,W0,W1,PW) do{ MF; sacc+=A0; sacc+=A1; sacc+=A2; sacc+=A3; PIN(sacc); W0; W1; PIN(PW); SBAR(); }while(0)
  #define EX(v) __builtin_amdgcn_exp2f(v)
  #define GAPB(MF,X,B) do{ MF; X[B]=EX(X[B]); X[B+1]=EX(X[B+1]); X[B+2]=EX(X[B+2]); X[B+3]=EX(X[B+3]); PIN(X); SBAR(); }while(0)
  #define VRD(i) do{ vlo[i]=vtr(vp_+(((i)>>2)*4096+((i)&3)*1024)); vhi[i]=vtr(vp_+(((i)>>2)*4096+((i)&3)*1024+512)); }while(0)
  #define KRD(G,j) do{ if(G){ kload2(kf,kp0+sl_next,j); SBAR(); } }while(0)
  #define STEP(C0,C1,P0,P1,t,GK,GV,GL) do{ SBAR(); \
    const lds_cptr vp_=vp0+sl_prev; \
    VRD(0); SBAR(); float sacc=(P0[0]+P0[1]); \
    GAPA(C0=__builtin_amdgcn_mfma_f32_32x32x16_bf16(kf[0],qr[0],(f32x16){},0,0,0), P0[2],P0[3],P0[4],P0[5],     pw0[0]=PKW(P0,0), pw0[1]=PKW(P0,2), pw0); \
    VRD(4); SBAR(); GAPA(C1=__builtin_amdgcn_mfma_f32_32x32x16_bf16(kf[1],qr[0],(f32x16){},0,0,0), P0[6],P0[7],P0[8],P0[9],     pw0[2]=PKW(P0,4), pw0[3]=PKW(P0,6), pw0); \
    VRD(1); SBAR(); GAPA(C0=__builtin_amdgcn_mfma_f32_32x32x16_bf16(kf[2],qr[1],C0,0,0,0),   P0[10],P0[11],P0[12],P0[13], pw1[0]=PKW(P0,8), pw1[1]=PKW(P0,10), pw1); \
    VRD(5); SBAR(); GAPA(C1=__builtin_amdgcn_mfma_f32_32x32x16_bf16(kf[3],qr[1],C1,0,0,0),   P0[14],P0[15],P1[0],P1[1],   pw1[2]=PKW(P0,12),pw1[3]=PKW(P0,14), pw1); \
    VRD(2); SBAR(); GAPA(C0=__builtin_amdgcn_mfma_f32_32x32x16_bf16(kf[4],qr[2],C0,0,0,0),   P1[2],P1[3],P1[4],P1[5],     pw2[0]=PKW(P1,0), pw2[1]=PKW(P1,2), pw2); \
    VRD(6); SBAR(); GAPA(C1=__builtin_amdgcn_mfma_f32_32x32x16_bf16(kf[5],qr[2],C1,0,0,0),   P1[6],P1[7],P1[8],P1[9],     pw2[2]=PKW(P1,4), pw2[3]=PKW(P1,6), pw2); \
    VRD(3); SBAR(); GAPA(C0=__builtin_amdgcn_mfma_f32_32x32x16_bf16(kf[6],qr[3],C0,0,0,0),   P1[10],P1[11],P1[12],P1[13], pw3[0]=PKW(P1,8), pw3[1]=PKW(P1,10), pw3); \
    VRD(7); SBAR(); GAPA(C1=__builtin_amdgcn_mfma_f32_32x32x16_bf16(kf[7],qr[3],C1,0,0,0),   P1[14],P1[15],0.f,0.f,       pw3[2]=PKW(P1,12),pw3[3]=PKW(P1,14), pw3); \
    l_reg+=sacc; \
    if(GK){DMA_K((t)+3,sl_cur);} if(GV){DMA_V((t)+1,sl_next);} \
    ADDK(C0,C1,t); CMASK(C0,C1,t); \
    { float a=MX3(C0[0],C0[1],C1[0]),b=MX3(C0[2],C0[3],C1[1]); a=MX3(a,C1[2],C1[3]); \
      _Pragma("unroll") for(int r=4;r<16;r+=4){a=MX3(a,C0[r],C0[r+1]);b=MX3(b,C0[r+2],C0[r+3]);a=MX3(a,C1[r],C1[r+1]);b=MX3(b,C1[r+2],C1[r+3]);} \
      float rm=__builtin_fmaxf(a,b); { auto rr=__builtin_amdgcn_permlane32_swap(__float_as_uint(rm),__float_as_uint(rm),false,false); rm=__builtin_fmaxf(__uint_as_float(rr[0]),__uint_as_float(rr[1])); } \
      resc=false; \
      if(__builtin_expect(__any(rm>(float)THRL),0)){ const float dl=__builtin_fmaxf(rm,0.f); mhat+=dl; \
        _Pragma("unroll") for(int r=0;r<16;++r){C0[r]-=dl;C1[r]-=dl;} \
         \
        const float f=__builtin_amdgcn_exp2f(-dl); l_reg*=f; if(hi==0)wsf[r32]=f; resc=true; } } \
    SBAR(); \
    GAPB(o[0]=__builtin_amdgcn_mfma_f32_32x32x16_bf16(PAF(0),VFR(0),o[0],0,0,0), C0,0); \
    GAPB(o[1]=__builtin_amdgcn_mfma_f32_32x32x16_bf16(PAF(0),VFR(4),o[1],0,0,0), C0,4); \
    KRD(GL,0); GAPB(o[0]=__builtin_amdgcn_mfma_f32_32x32x16_bf16(PAF(1),VFR(1),o[0],0,0,0), C0,8); \
    KRD(GL,1); GAPB(o[1]=__builtin_amdgcn_mfma_f32_32x32x16_bf16(PAF(1),VFR(5),o[1],0,0,0), C0,12); \
    KRD(GL,2); GAPB(o[0]=__builtin_amdgcn_mfma_f32_32x32x16_bf16(PAF(2),VFR(2),o[0],0,0,0), C1,0); \
    KRD(GL,3); GAPB(o[1]=__builtin_amdgcn_mfma_f32_32x32x16_bf16(PAF(2),VFR(6),o[1],0,0,0), C1,4); \
    GAPB(o[0]=__builtin_amdgcn_mfma_f32_32x32x16_bf16(PAF(3),VFR(3),o[0],0,0,0), C1,8); \
    GAPB(o[1]=__builtin_amdgcn_mfma_f32_32x32x16_bf16(PAF(3),VFR(7),o[1],0,0,0), C1,12); \
    }while(0)
  int t=1;
  #undef CMASK
  #define CMASK(P0,P1,t) do{}while(0)
  for(;t+5<NT;t+=2){
    STEP(pB0,pB1,pA0,pA1,t,true,true,true);     WAIT_BAR(2); RESC(); ROT();
    STEP(pA0,pA1,pB0,pB1,t+1,true,true,true);   WAIT_BAR(2); RESC(); ROT();
  }
  #undef CMASK
  #define CMASK(P0,P1,t) do{int jb_=(t)-band0; if(jb_>=0)cmask(P0,P1,jb_,qrel,hi);}while(0)
  #define ENDW(tt) do{ if((tt)+3<NT){WAIT_BAR(2);} else if((tt)+2<NT){WAIT_BAR(1);} else {WAIT_BAR(0);} }while(0)
  for(;t+1<NT;t+=2){
    STEP(pB0,pB1,pA0,pA1,t,(t+3<NT),(t+1<NT),(t+1<NT));       ENDW(t);   RESC(); ROT();
    STEP(pA0,pA1,pB0,pB1,t+1,(t+4<NT),(t+2<NT),(t+2<NT));     ENDW(t+1); RESC(); ROT();
  }
  STEP(pB0,pB1,pA0,pA1,NT-1,false,false,false); RESC();
  { float sacc=pB0[0]+pB0[1]; _Pragma("unroll") for(int r=2;r<16;++r)sacc+=pB0[r]; _Pragma("unroll") for(int r=0;r<16;++r)sacc+=pB1[r]; l_reg+=sacc;
    pw0=(u32x4){PKW(pB0,0),PKW(pB0,2),PKW(pB0,4),PKW(pB0,6)};pw1=(u32x4){PKW(pB0,8),PKW(pB0,10),PKW(pB0,12),PKW(pB0,14)};pw2=(u32x4){PKW(pB1,0),PKW(pB1,2),PKW(pB1,4),PKW(pB1,6)};pw3=(u32x4){PKW(pB1,8),PKW(pB1,10),PKW(pB1,12),PKW(pB1,14)};
    SBAR(); pv(o,vb0+sl_cur,PAF(0),PAF(1),PAF(2),PAF(3)); }
  #undef PKW
  #undef PAF
  #undef VFR
  #undef PIN
  #undef MX3
  #undef GAPA
  #undef GAPB
  #undef EX
  #undef VRD
  #undef KRD
  #undef STEP
  #undef ENDW
  {auto rr=__builtin_amdgcn_permlane32_swap(__float_as_uint(l_reg),__float_as_uint(l_reg),false,false);l_reg=__uint_as_float(rr[0])+__uint_as_float(rr[1]);}
  if(hi==0)wsf[32+r32]=l_reg;asm volatile("s_waitcnt lgkmcnt(0)":::"memory");
  float rli[16];
  #pragma unroll
  for(int r=0;r<16;++r)rli[r]=__builtin_amdgcn_rcpf(wsf[32+crow(r,hi)]);
  bf16*Ow=O+(rowbase+q0+wid*QBLK)*PO+h*D;
  { bf16*stg=(bf16*)(shm+LDS_OST)+wid*2048;
    #pragma unroll
    for(int r=0;r<16;++r){const int orow=crow(r,hi);
      #pragma unroll
      for(int d0=0;d0<2;++d0)stg[orow*64+d0*32+r32]=__float2bfloat16(o[d0][r]*rli[r]);}
    asm volatile("s_waitcnt lgkmcnt(0)":::"memory");
    #pragma unroll
    for(int i=0;i<4;++i){const int row=i*8+(lane>>3),ch=lane&7; const u32x4 v=*(const u32x4*)(stg+row*64+ch*8); if(q0+wid*QBLK+row<TTOK)ATTN_STORE16(Ow+(long)row*PO+ch*8,v);} }
  asm volatile("s_waitcnt lgkmcnt(0)\n\ts_barrier":::"memory");
  #undef ADDK
  #undef DMA_K
  #undef DMA_V
  #undef CMASK
  #undef START
  #undef RESC
  #undef ROT
}
constexpr int QA_OFF=0,KA_OFF=512,VA_OFF=640;
__device__ __forceinline__ void swa_unit(int lb,int kvh,int a,const bf16*__restrict__ P,bf16*OC,const float*__restrict__ rel,const float*__restrict__ sinks,char*shm){
  const int tid=threadIdx.x,lane=tid&63,r32=lane&31,hi=lane>>5; const int wid=__builtin_amdgcn_readfirstlane(tid>>6);
  const int g=wid>>1,half=wid&1,hq=kvh*4+g;
  const long rowbase=(long)lb*TTOK;
  const unsigned lds0=(unsigned)(uintptr_t)shm; const lds_cptr shm3=(lds_cptr)shm;
  float*wsf=(float*)(shm+LDS_WS)+wid*64;
  const float LOG2E=1.4426950408889634f;
  { const int gg=tid>>7,d=tid&127; int bk=d; if(d>=16){ bk=16+(int)(logf((float)d*(1.f/16.f))*(16.f/2.0794415416798357f)); if(bk>31)bk=31; }
    ((__attribute__((address_space(3))) float*)(shm3+LDS_DK))[tid]=rel[bk*8+kvh*4+gg]*LOG2E; }
  const int t_lo=a>=2?a-2:0; const int ntile=a-t_lo+1;
  const bf16*Kh=P+rowbase*PQ+KA_OFF+kvh*64,*Vh=P+rowbase*PQ+VA_OFF+kvh*64;
  const bf16*ksrc=Kh+(long)lane*PQ+wid*8;
  const bf16*vsrc=Vh+(long)(16*(wid&3)+(lane>>2))*PQ+(wid>>2)*32+(lane&3)*8;
  #pragma unroll
  for(int j=0;j<3;++j) if(j<ntile){
    glds16(ksrc+(long)(t_lo+j)*KVBLK*PQ,(unsigned)__builtin_amdgcn_readfirstlane(lds0+LDS_K+wid*1024+j*SLOTB));
    glds16(vsrc+(long)(t_lo+j)*KVBLK*PQ,(unsigned)__builtin_amdgcn_readfirstlane(lds0+LDS_V+wid*1024+j*SLOTB)); }
  const int qpos=64*a+32*half+r32;
  const bf16*Qw=P+(rowbase+64*a+32*half)*PQ+QA_OFF+hq*64;
  bf16x8 qr[4];
  #pragma unroll
  for(int d0=0;d0<4;++d0)qr[d0]=*reinterpret_cast<const bf16x8*>(&Qw[(long)r32*PQ+d0*16+hi*8]);
  const float sink2=sinks[hq]*LOG2E;
  asm volatile("s_waitcnt vmcnt(0) lgkmcnt(0)\n\ts_barrier":::"memory");
  f32x16 S0[3],S1[3]; f32x16 zero=f32x16{};
  #pragma unroll
  for(int j=0;j<3;++j){ S0[j]=f32x16{}; S1[j]=f32x16{}; if(j<ntile){ qkt(S0[j],S1[j],shm+LDS_K+j*SLOTB,qr,zero,r32,hi); } }
  const __attribute__((address_space(3))) float* bt=(const __attribute__((address_space(3))) float*)(shm3+LDS_DK)+g*128;
  float mx=sink2;
  #pragma unroll
  for(int j=0;j<3;++j){
    #pragma unroll
    for(int r=0;r<16;++r){
      const int kv=64*(t_lo+j)+crow(r,hi); const int d0_=qpos-kv, d1_=d0_-32;
      const bool ok0=(j<ntile)&&(d0_>=0)&&(d0_<128), ok1=(j<ntile)&&(d1_>=0)&&(d1_<128);
      const float s0=ok0?S0[j][r]+bt[d0_&127]:-INFINITY, s1=ok1?S1[j][r]+bt[d1_&127]:-INFINITY;
      S0[j][r]=s0; S1[j][r]=s1; mx=fmaxf(mx,fmaxf(s0,s1)); } }
  mx=fmaxf(mx,__shfl_xor(mx,32));
  float l=0.f;
  #pragma unroll
  for(int j=0;j<3;++j){
    #pragma unroll
    for(int r=0;r<16;++r){ const float p0=__builtin_amdgcn_exp2f(S0[j][r]-mx), p1=__builtin_amdgcn_exp2f(S1[j][r]-mx); S0[j][r]=p0; S1[j][r]=p1; l+=p0+p1; } }
  l+=__shfl_xor(l,32); l+=__builtin_amdgcn_exp2f(sink2-mx);
  f32x16 o[2]; o[0]=f32x16{}; o[1]=f32x16{};
  const int vb0=(int)(lds0+LDS_V)+((lane>>4)&1)*32+(lane&3)*8+(4*hi+((lane&15)>>2))*64;
  #define PKW(P,B) cvtpk_s(P[B],P[B+1])
  #pragma unroll
  for(int j=0;j<3;++j) if(j<ntile){
    u32x4 pw0=(u32x4){PKW(S0[j],0),PKW(S0[j],2),PKW(S0[j],4),PKW(S0[j],6)},pw1=(u32x4){PKW(S0[j],8),PKW(S0[j],10),PKW(S0[j],12),PKW(S0[j],14)};
    u32x4 pw2=(u32x4){PKW(S1[j],0),PKW(S1[j],2),PKW(S1[j],4),PKW(S1[j],6)},pw3=(u32x4){PKW(S1[j],8),PKW(S1[j],10),PKW(S1[j],12),PKW(S1[j],14)};
    pv(o,vb0+j*SLOTB,__builtin_bit_cast(bf16x8,pw0),__builtin_bit_cast(bf16x8,pw1),__builtin_bit_cast(bf16x8,pw2),__builtin_bit_cast(bf16x8,pw3)); }
  #undef PKW
  if(hi==0)wsf[32+r32]=l; asm volatile("s_waitcnt lgkmcnt(0)":::"memory");
  float rli[16];
  #pragma unroll
  for(int r=0;r<16;++r)rli[r]=__builtin_amdgcn_rcpf(wsf[32+crow(r,hi)]);
  bf16*Ow=OC+(rowbase+64*a+32*half)*PO+hq*64;
  { bf16*stg=(bf16*)(shm+LDS_OST)+wid*2048;
    #pragma unroll
    for(int r=0;r<16;++r){const int orow=crow(r,hi);
      #pragma unroll
      for(int d0=0;d0<2;++d0)stg[orow*64+d0*32+r32]=__float2bfloat16(o[d0][r]*rli[r]);}
    asm volatile("s_waitcnt lgkmcnt(0)":::"memory");
    #pragma unroll
    for(int i=0;i<4;++i){const int row=i*8+(lane>>3),ch=lane&7; const u32x4 v=*(const u32x4*)(stg+row*64+ch*8); if(64*a+32*half+row<TTOK)*(u32x4*)(Ow+(long)row*PO+ch*8)=v;} }
  asm volatile("s_waitcnt lgkmcnt(0)\n\ts_barrier":::"memory");
}
#undef SBAR
#undef WAIT_BAR
}

#define GAS __attribute__((address_space(1)))
#define LAS __attribute__((address_space(3)))
typedef unsigned short bf16;
typedef unsigned v4u __attribute__((ext_vector_type(4)));
typedef float f32x4 __attribute__((ext_vector_type(4)));
typedef short bf16x8 __attribute__((ext_vector_type(8)));
typedef GAS unsigned gu32;
typedef GAS unsigned long long gu64;
#define RLX_AGENT __ATOMIC_RELAXED, __HIP_MEMORY_SCOPE_AGENT
#define LDS_WAIT() asm volatile("s_waitcnt lgkmcnt(0)" ::: "memory")
#define VM_WAIT() asm volatile("s_waitcnt vmcnt(0)" ::: "memory")
__device__ __forceinline__ unsigned long long rt() { return __builtin_amdgcn_s_memrealtime(); }
__device__ __forceinline__ unsigned f2bf(float f) { unsigned u = __builtin_bit_cast(unsigned, f); return (u + 0x7fffu + ((u >> 16) & 1u)) >> 16; }
__device__ __forceinline__ unsigned pk2(float lo, float hi) { return f2bf(lo) | (f2bf(hi) << 16); }

#define XB_TMO      128
#define XB_XCNT(j)  (256  + 64 * (j))
#define XB_XSUB(j)  (1280 + 64 * (j))
#define XB_XGEN(j)  (2304 + 64 * (j))
#define XB_TOP      3328
#define XB_TOPGEN   3392
#define XCD_BAR_WORDS 3456
#define XB_SPIN_CAP (1u << 18)

__device__ __forceinline__ unsigned xb_ld(unsigned* p)              { return __hip_atomic_load(p, __ATOMIC_RELAXED, __HIP_MEMORY_SCOPE_AGENT); }
__device__ __forceinline__ unsigned xb_add(unsigned* p, unsigned v) { return __hip_atomic_fetch_add(p, v, __ATOMIC_RELAXED, __HIP_MEMORY_SCOPE_AGENT); }
__device__ __forceinline__ unsigned xb_xcc_id() { return (unsigned)__builtin_amdgcn_s_getreg((3 << 11) | 20) & 0xFu; }
#define XB_SPIN(cond, bar) do { unsigned _sp = 0; while (cond) { __builtin_amdgcn_s_sleep(1); \
    if ((++_sp & 255u) == 0u) { if (xb_ld(&(bar)[XB_TMO])) break; if (_sp > XB_SPIN_CAP) { atomicAdd(&(bar)[XB_TMO], 1u); break; } } } } while (0)

struct XcdBarrier {
    unsigned* bar; unsigned x;
    volatile LAS unsigned* st;
};

__device__ __forceinline__ XcdBarrier xcd_barrier_post(unsigned* bar, volatile LAS unsigned* st) {
    XcdBarrier b; b.bar = bar; b.x = xb_xcc_id(); b.st = st;
    if (threadIdx.x == 0) (void)xb_add(&bar[XB_XCNT(b.x)], 1u);
    return b;
}
__device__ __forceinline__ void xcd_barrier_complete(unsigned* bar, unsigned x, unsigned& nloc, unsigned& nx) {
    const unsigned G = gridDim.x * gridDim.y * gridDim.z;
    unsigned sum, cnt, mine, sp = 0u;
    for (;;) {
        sum = 0u; cnt = 0u; mine = 0u;
#pragma unroll
        for (unsigned j = 0; j < 16; ++j) { const unsigned c = xb_ld(&bar[XB_XCNT(j)]); sum += c; cnt += (c > 0u) ? 1u : 0u; mine = (j == x) ? c : mine; }
        if (sum == G) break;
        __builtin_amdgcn_s_sleep(1);
        if ((++sp & 255u) == 0u) { if (xb_ld(&bar[XB_TMO])) break; if (sp > XB_SPIN_CAP) { atomicAdd(&bar[XB_TMO], 1u); break; } }
    }
    nloc = mine > 0u ? mine : 1u; nx = cnt > 0u ? cnt : 1u;
}

__device__ __forceinline__ void xcd_barrier(const XcdBarrier& b) {
    asm volatile("s_waitcnt vmcnt(0)" ::: "memory");
    __syncthreads();
    if (threadIdx.x == 0) {
        unsigned* bar = b.bar;
        __builtin_amdgcn_s_waitcnt(0);
        unsigned nloc = b.st[0], nx = b.st[1];
        if (nloc == 0u) { xcd_barrier_complete(bar, b.x, nloc, nx); b.st[0] = nloc; b.st[1] = nx; }
        const unsigned old = xb_add(&bar[XB_XSUB(b.x)], 1u);
        const unsigned gen = old / nloc;
        if (old + 1u == (gen + 1u) * nloc) {
            __builtin_amdgcn_fence(__ATOMIC_RELEASE, "agent");
            asm volatile("s_waitcnt vmcnt(0)" ::: "memory");
            const unsigned og = xb_add(&bar[XB_TOP], 1u);
            const unsigned tg = og / nx;
            if (og + 1u == (tg + 1u) * nx) xb_add(&bar[XB_TOPGEN], 1u);
            else XB_SPIN(xb_ld(&bar[XB_TOPGEN]) == tg, bar);
            __builtin_amdgcn_fence(__ATOMIC_ACQUIRE, "agent");
            xb_add(&bar[XB_XGEN(b.x)], 1u);
            asm volatile("s_waitcnt vmcnt(0)" ::: "memory");
        } else {
            XB_SPIN(xb_ld(&bar[XB_XGEN(b.x)]) == gen, bar);
            __builtin_amdgcn_fence(__ATOMIC_ACQUIRE, "agent");
            asm volatile("s_waitcnt vmcnt(0)" ::: "memory");
        }
    }
    __syncthreads();
}

constexpr int NWAVES = 8;
constexpr int T_TOK = 4112, M_TOK = 32896, DMODEL = 1024, NPROJ = 6656, DFF = 2816, MP = 33280;
constexpr int HALF_ROWS = 4 * T_TOK  , NT_HALF = 65, MLOC = 16896  ;
constexpr int QA_OFF = 0, KA_OFF = 512, VA_OFF = 640, QF_OFF = 768, KF_OFF = 1280, VF_OFF = 1792, XC_OFF = 2304, YC_OFF = 2816, GATE_OFF = 3328, FL_OFF = 6400;
constexpr int LRU_CH = 129;
constexpr float C2 = 0.125f * 1.4426950408889634f, LOG2E = 1.4426950408889634f;
constexpr size_t MiB = 1u << 20;
constexpr size_t WS_CTL = 0, CTL_ZERO_BYTES = 64 * 1024;
constexpr size_t WS_SSQA = 1 * MiB, WS_SSQB = WS_SSQA + 512 * 1024, WS_HMETA = 2 * MiB  , WS_FL = 3 * MiB  , WS_DK = 4 * MiB  ;
constexpr size_t WS_LRUP = 5 * MiB  , WS_LRUH = 7 * MiB;
constexpr size_t WS_WIN = 9 * MiB;
constexpr size_t WS_WB = WS_WIN + 13 * MiB;
constexpr size_t WS_WOUT = WS_WB + 3 * MiB;
constexpr size_t WS_WFFI = WS_WOUT + 2 * MiB;
constexpr size_t WS_WFFO = WS_WFFI + 11 * MiB;
constexpr size_t WS_WR = WS_WFFO + 6 * MiB, WS_WI = WS_WR + 65536;
constexpr size_t WS_HB = 46 * MiB;
constexpr size_t WS_MG = WS_HB + 65 * MiB;
constexpr size_t WS_OC = WS_MG + 65 * MiB;
constexpr size_t WS_PROJ = WS_OC + 50 * MiB;
constexpr size_t WS_END = WS_PROJ + 215 * MiB;
static_assert(WS_WI + 65536 <= WS_HB && (size_t)MP * 1024 * 2 <= 65 * MiB && (size_t)MLOC * 1536 * 2 <= 50 * MiB && (size_t)MLOC * NPROJ * 2 <= 215 * MiB && (size_t)MP * DFF * 2 <= 215 * MiB && WS_END <= 512 * MiB, "ws map");
constexpr int CW_BAR = 4096;
constexpr int RING_BYTES = 131072, MISC_OFF = RING_BYTES + 320, LDS_BYTES = 147456;

using pg8::sigmoid_f;
struct Args { const float* in[20]; float* out; unsigned char* ws; int ph_lo, ph_hi; };
struct Frame {
    LAS unsigned char* lds; int tid, lane, wave, G, bid;
    float* out; unsigned char* ws;
};
__device__ __forceinline__ float wave_sum(float v) {
#pragma unroll
    for (int o = 1; o < 64; o <<= 1) v += __shfl_xor(v, o);
    return v;
}
__device__ __forceinline__ float* hrow(const Frame& F, int m) { const int b = m / T_TOK, t = m - b * T_TOK; return (t < 16) ? (float*)(F.ws + WS_HMETA) + (size_t)(b * 16 + t) * DMODEL : F.out + ((size_t)b * 4096 + (t - 16)) * DMODEL; }

__device__ __forceinline__ void wt_item(const float* __restrict__ W, int ldn, int s0, int nv, int K, bf16* WT, int n0, const float* __restrict__ kscale, float cs, LAS float* scr, int kb, int lane) {
    const int k0 = 64 * kb;
#pragma unroll 8
    for (int i = 0; i < 32; ++i) { const int kk = 2 * i + (lane >> 5), n = lane & 31; float v = 0.f;
        if (n < nv) { v = W[(size_t)(k0 + kk) * ldn + s0 + n] * cs; if (kscale) v *= kscale[k0 + kk]; }
        scr[kk * 33 + n] = v; }
    LDS_WAIT(); asm volatile("" ::: "memory");
    const int c = lane & 7;
#pragma unroll
    for (int j = 0; j < 4; ++j) { const int n = (lane >> 3) + 8 * j; const LAS float* s = scr + (8 * c) * 33 + n;
        v4u o; o.x = pk2(s[0 * 33], s[1 * 33]); o.y = pk2(s[2 * 33], s[3 * 33]); o.z = pk2(s[4 * 33], s[5 * 33]); o.w = pk2(s[6 * 33], s[7 * 33]);
        *(GAS v4u*)(WT + (size_t)(n0 + n) * K + k0 + 8 * c) = o; }
    LDS_WAIT(); asm volatile("" ::: "memory");
}
__device__ __forceinline__ void wconv_phase(Frame& F, int l, const float* norm_mix, const float* w_in, const float* lru_wr, const float* lru_wi, const float* w_branch, const float* w_out, const float* norm_ffn, const float* w_ffi, const float* w_ffo) {
    LAS float* scr = (LAS float*)(F.lds + F.wave * 16384);
    const int gw = F.bid * NWAVES + F.wave, NGW = F.G * NWAVES;
    constexpr int I_IN = 16 * 208, I_FFI = 16 * 176, I_WB = 3 * 8 * 32, I_OUT = 16 * 32, I_FFO = 44 * 32, I_LRU = 2 * 8 * 2;
    constexpr int NITEMS = I_IN + I_FFI + I_WB + I_OUT + I_FFO + I_LRU;
    bf16* Win_t = (bf16*)(F.ws + WS_WIN); bf16* Wb_t = (bf16*)(F.ws + WS_WB); bf16* Wout_t = (bf16*)(F.ws + WS_WOUT); bf16* Wffi_t = (bf16*)(F.ws + WS_WFFI); bf16* Wffo_t = (bf16*)(F.ws + WS_WFFO);
    for (int it = gw; it < NITEMS; it += NGW) {
        int r = it;
        if (r < I_IN) { const int kb = r / 208, nb = r % 208, n0 = 32 * nb; int s0, nv = 32; float cs = 1.f;
            if (n0 < 2304) { s0 = n0; if (n0 < 512 || (n0 >= 768 && n0 < 1280)) cs = C2; } else if (n0 < 6400) s0 = n0 + 8; else if (n0 == 6400) { s0 = 2304; nv = 8; } else { s0 = 0; nv = 0; }
            wt_item(w_in + (size_t)l * 1024 * 6408, 6408, s0, nv, 1024, Win_t, n0, norm_mix + l * 1024, cs, scr, kb, F.lane); continue; } r -= I_IN;
        if (r < I_FFI) { const int kb = r / 176, nb = r % 176, n0 = 32 * nb, pn = n0 >> 8, w = n0 & 255; const int s0 = (w < 128) ? 128 * pn + w : 2816 + 128 * pn + (w - 128);
            wt_item(w_ffi + (size_t)l * 1024 * 5632, 5632, s0, 32, 1024, Wffi_t, n0, norm_ffn + l * 1024, 1.f, scr, kb, F.lane); continue; } r -= I_FFI;
        if (r < I_WB) { const int g = r / 256, q = r % 256, kb = q / 32, nb = q % 32;
            wt_item(w_branch + (size_t)(l * 3 + g) * 512 * 1024, 1024, 32 * nb, 32, 512, Wb_t, g * 1024 + 32 * nb, nullptr, 1.f, scr, kb, F.lane); continue; } r -= I_WB;
        if (r < I_OUT) { const int kb = r / 32, nb = r % 32;
            wt_item(w_out + (size_t)l * 1024 * 1024, 1024, 32 * nb, 32, 1024, Wout_t, 32 * nb, nullptr, 1.f, scr, kb, F.lane); continue; } r -= I_OUT;
        if (r < I_FFO) { const int kb = r / 32, nb = r % 32;
            wt_item(w_ffo + (size_t)l * 2816 * 1024, 1024, 32 * nb, 32, 2816, Wffo_t, 32 * nb, nullptr, 1.f, scr, kb, F.lane); continue; } r -= I_FFO;
        { const int mat = r / 16, q = r % 16, h = q / 2, nb = q % 2;
            wt_item((mat ? lru_wi : lru_wr) + (size_t)(l * 8 + h) * 4096, 64, 32 * nb, 32, 64, (bf16*)(F.ws + (mat ? WS_WI : WS_WR)) + h * 4096, 32 * nb, nullptr, 1.f, scr, 0, F.lane); }
    }
}
__device__ __forceinline__ void init_phase(Frame& F, const float* x, const float* meta) {
    const int gw = F.bid * NWAVES + F.wave, NGW = F.G * NWAVES;
    bf16* hb = (bf16*)(F.ws + WS_HB); unsigned long long* ssqA = (unsigned long long*)(F.ws + WS_SSQA); unsigned long long* ssqB = (unsigned long long*)(F.ws + WS_SSQB);
    for (int m = gw; m < MP; m += NGW) {
        GAS unsigned long long* o8 = (GAS unsigned long long*)(hb + (size_t)m * DMODEL) + F.lane;
        if (m < M_TOK) { const int b = m / T_TOK, t = m - b * T_TOK;
            const float* src = (t < 16) ? meta + (size_t)t * DMODEL : x + ((size_t)b * 4096 + (t - 16)) * DMODEL;
            const GAS f32x4* xr = (const GAS f32x4*)src + F.lane; GAS f32x4* hr = (GAS f32x4*)hrow(F, m) + F.lane;
            float s = 0.f;
#pragma unroll
            for (int j = 0; j < 4; ++j) { const f32x4 v = xr[64 * j]; hr[64 * j] = v; s += (v.x * v.x + v.y * v.y) + (v.z * v.z + v.w * v.w);
                o8[64 * j] = (unsigned long long)pk2(v.x, v.y) | ((unsigned long long)pk2(v.z, v.w) << 32); }
            s = wave_sum(s); if (F.lane == 0) { ssqB[m] = (unsigned long long)(s * 1048576.0f); ssqA[m] = 0ull; }
        } else {
#pragma unroll
            for (int j = 0; j < 4; ++j) o8[64 * j] = 0ull;
            if (F.lane == 0) { ssqB[m] = 0ull; ssqA[m] = 0ull; }
        }
    }
}
__device__ __forceinline__ void final_phase(Frame& F, const float* norm_final) {
    const int gw = F.bid * NWAVES + F.wave, NGW = F.G * NWAVES; const unsigned long long* ssqB = (const unsigned long long*)(F.ws + WS_SSQB);
    for (int r = gw; r < 32768; r += NGW) { const int b = r >> 12, tt = r & 4095, m = b * T_TOK + 16 + tt;
        const float s = rsqrtf((float)ssqB[m] * (1.0f / (1024.0f * 1048576.0f)) + 1e-6f);
        GAS f32x4* hr = (GAS f32x4*)(F.out + (size_t)r * DMODEL) + F.lane; const GAS f32x4* gr = (const GAS f32x4*)norm_final + F.lane;
#pragma unroll
        for (int j = 0; j < 4; ++j) { f32x4 v = hr[64 * j]; const f32x4 g = gr[64 * j]; v = v * s * g; hr[64 * j] = v; } }
}
__device__ __forceinline__ void zero_u64(Frame& F, unsigned long long* p, int n) { for (int i = F.bid * NWAVES * 64 + F.tid; i < n; i += F.G * NWAVES * 64) p[i] = 0ull; }

__device__ __forceinline__ float logsig_f(float x) { return fminf(x, 0.f) - log1pf(__expf(-fabsf(x))); }
__device__ __forceinline__ void cumsum_unit(Frame& F, int l, int lb, const float* fbias) {
    const int h = F.wave, lane = F.lane; const float* fl = (const float*)(F.ws + WS_FL); float* dk = (float*)(F.ws + WS_DK) + (size_t)(lb * 8 + h) * 4352;
    const float fb = fbias[l * 8 + h]; float carry = 0.f;
    for (int cq = 0; cq < 17; ++cq) { const int t0 = 256 * cq + 4 * lane; float v[4];
#pragma unroll
        for (int j = 0; j < 4; ++j) { const int t = t0 + j; v[j] = (t < T_TOK) ? logsig_f(fl[(size_t)(lb * T_TOK + t) * 8 + h] + fb) : 0.f; }
        v[1] += v[0]; v[2] += v[1]; v[3] += v[2];
        float inc = v[3];
#pragma unroll
        for (int o = 1; o < 64; o <<= 1) { const float u = __shfl_up(inc, o); if (lane >= o) inc += u; }
        const float ex = carry + inc - v[3];
        f32x4 o4 = { -(ex + v[0]) * LOG2E, -(ex + v[1]) * LOG2E, -(ex + v[2]) * LOG2E, -(ex + v[3]) * LOG2E };
        *(f32x4*)(dk + t0) = o4;
        carry += __shfl(inc, 63);
    }
}
__device__ __forceinline__ float bf2f(unsigned short u) { return __uint_as_float((unsigned)u << 16); }
__device__ __forceinline__ int crow_(int r, int hi) { return (r & 3) + 8 * (r >> 2) + 4 * hi; }
template <int MODE> __device__ __forceinline__ void lru_unit(Frame& F, int l, int lb, int ch, const float* conv_w, const float* conv_b, const float* lru_br, const float* lru_bi, const float* lam) {
    typedef float f32x16 __attribute__((ext_vector_type(16)));
    const int tid = F.tid, wid = F.wave, lane = F.lane, c = tid, r32 = lane & 31, hi = lane >> 5;
    const bf16* proj = (const bf16*)(F.ws + WS_PROJ);
    const int t0 = ch * 32, nt = (T_TOK - t0) < 32 ? (T_TOK - t0) : 32;
    const bf16* xcp = proj + (size_t)(lb * T_TOK) * NPROJ + XC_OFF + c;
    LAS unsigned short* XCb = (LAS unsigned short*)(F.lds);
    LAS float* MU = (LAS float*)(F.lds);
    LAS float* AS = (LAS float*)(F.lds + 65536);
    float xcv[32];
    { const float w0 = conv_w[(l * 4 + 0) * 512 + c], w1 = conv_w[(l * 4 + 1) * 512 + c], w2 = conv_w[(l * 4 + 2) * 512 + c], w3 = conv_w[(l * 4 + 3) * 512 + c], cb = conv_b[l * 512 + c];
        float xm3 = (t0 >= 3) ? bf2f(xcp[(size_t)(t0 - 3) * NPROJ]) : 0.f, xm2 = (t0 >= 2) ? bf2f(xcp[(size_t)(t0 - 2) * NPROJ]) : 0.f, xm1 = (t0 >= 1) ? bf2f(xcp[(size_t)(t0 - 1) * NPROJ]) : 0.f;
#pragma unroll
        for (int t = 0; t < 32; ++t) { const float x0 = (t < nt) ? bf2f(xcp[(size_t)(t0 + t) * NPROJ]) : 0.f;
            xcv[t] = w0 * xm3 + w1 * xm2 + w2 * xm1 + w3 * x0 + cb; xm3 = xm2; xm2 = xm1; xm1 = x0;
            XCb[t * 520 + c] = (unsigned short)f2bf(xcv[t]); } }
    __syncthreads();
    bf16x8 af[4];
#pragma unroll
    for (int ks = 0; ks < 4; ++ks) af[ks] = *(const LAS bf16x8*)(XCb + r32 * 520 + 64 * wid + 16 * ks + 8 * hi);
    __syncthreads();
    f32x16 dr[2], di[2];
    { const bf16* Wr = (const bf16*)(F.ws + WS_WR) + wid * 4096; const bf16* Wi = (const bf16*)(F.ws + WS_WI) + wid * 4096;
#pragma unroll
        for (int jt = 0; jt < 2; ++jt) { dr[jt] = f32x16{}; di[jt] = f32x16{};
#pragma unroll
            for (int ks = 0; ks < 4; ++ks) { const bf16x8 br = *(const bf16x8*)(Wr + (jt * 32 + r32) * 64 + 16 * ks + 8 * hi), bi = *(const bf16x8*)(Wi + (jt * 32 + r32) * 64 + 16 * ks + 8 * hi);
                dr[jt] = __builtin_amdgcn_mfma_f32_32x32x16_bf16(af[ks], br, dr[jt], 0, 0, 0); di[jt] = __builtin_amdgcn_mfma_f32_32x32x16_bf16(af[ks], bi, di[jt], 0, 0, 0); } } }
#pragma unroll
    for (int jt = 0; jt < 2; ++jt) { const int cc = 64 * wid + 32 * jt + r32; const float brv = lru_br[l * 512 + cc], biv = lru_bi[l * 512 + cc], lsl = 8.0f * logsig_f(lam[l * 512 + cc]);
#pragma unroll
        for (int r = 0; r < 16; ++r) { const int t = crow_(r, hi); const float rr = sigmoid_f(dr[jt][r] + brv), gi = sigmoid_f(di[jt][r] + biv), la = rr * lsl;
            AS[t * 512 + cc] = __expf(la); MU[t * 512 + cc] = sqrtf(-expm1f(2.0f * la)) * gi; } }
    __syncthreads();
    float* lp = (float*)(F.ws + WS_LRUP) + (size_t)(lb * LRU_CH) * 512 + c; float* lh = (float*)(F.ws + WS_LRUH) + (size_t)(lb * LRU_CH) * 512 + c;
    float h = 0.f, pa = 1.f;
    if (MODE == 1) {
#pragma unroll 16
        for (int k = 0; k < ch; ++k) h = lp[(size_t)k * 512] * h + lh[(size_t)k * 512];
    }
    const bf16* ycp = proj + (size_t)(lb * T_TOK + t0) * NPROJ + YC_OFF + c;
    bf16* ocp = (bf16*)(F.ws + WS_OC) + (size_t)(lb * T_TOK + t0) * 1536 + 1024 + c;
#pragma unroll
    for (int t = 0; t < 32; ++t) if (t < nt) { const float a = AS[t * 512 + c]; h = a * h + MU[t * 512 + c] * xcv[t]; pa *= a;
        if (MODE == 1) { const float y = bf2f(*(const unsigned short*)(ycp + (size_t)t * NPROJ)); const float u = 0.7978845608028654f * (y + 0.044715f * y * y * y);
            const float th = 1.f - 2.f * __builtin_amdgcn_rcpf(1.f + __expf(2.f * u)); const float ge = 0.5f * y * (1.f + th);
            *(unsigned short*)(ocp + (size_t)t * 1536) = (unsigned short)f2bf(h * ge); } }
    if (MODE == 0) { lp[(size_t)ch * 512] = pa; lh[(size_t)ch * 512] = h; }
    __syncthreads();
}

#ifndef ONE_LAUNCH
#define ONE_LAUNCH 0
#endif
#define INP(k) (args.in[k])
enum { ST_INIT = 0, ST_WCONV, ST_G1, ST_S1, ST_S2, ST_S3, ST_G4, ST_G5, ST_G6, ST_FINAL };
template <int ST> __device__ __forceinline__ void run_stage(Frame& F, const Args& args, unsigned char* lds, int l, int half) {
    unsigned char* ws = F.ws;
    bf16* hb = (bf16*)(ws + WS_HB); bf16* mg = (bf16*)(ws + WS_MG); bf16* oc = (bf16*)(ws + WS_OC); bf16* proj = (bf16*)(ws + WS_PROJ);
    unsigned long long* ssqA = (unsigned long long*)(ws + WS_SSQA); unsigned long long* ssqB = (unsigned long long*)(ws + WS_SSQB);
    const int grow0 = half * HALF_ROWS;
    if constexpr (ST == ST_INIT) { init_phase(F, INP(0), INP(1)); }
    if constexpr (ST == ST_INIT || ST == ST_WCONV) { wconv_phase(F, l, INP(3), INP(4), INP(9), INP(11), INP(14), INP(15), INP(16), INP(17), INP(18)); }
    if constexpr (ST == ST_FINAL) { final_phase(F, INP(19)); }
    if constexpr (ST == ST_G1) {
                    pg8::Gemm g{(const pg8::bf16_t*)(hb + (size_t)grow0 * DMODEL), (const pg8::bf16_t*)(ws + WS_WIN)};
                    typedef pg8::Order<NT_HALF, 26, 1> Ord; Ord S; S.init(F.G, F.bid);
                    pg8::EpiProj E{(pg8::bf16_t*)proj, (float*)(ws + WS_FL), ssqB, grow0};

pg8::gemm_phase<pg8::EpiProj, Ord, true, true, 1024, 1024, 0, 0>(F.lds, g, S, E);
    }
    if constexpr (ST == ST_S1) {
                    constexpr int N_SWA = 4 * 2 * 65, N_LRU = 4 * LRU_CH, N_CS = 4;
                    for (int u = F.bid; u < N_CS + N_SWA + N_LRU; u += F.G) {
                        if (u < N_CS) { cumsum_unit(F, l, u, INP(6)); }
                        else if (u < N_CS + N_SWA) { const int v = u - N_CS, lb = v / 130, w = v % 130;
                            attn_body::swa_unit(lb, w / 65, w % 65, (const attn_body::bf16*)proj, (attn_body::bf16*)oc, INP(2), INP(5) + l * 8, (char*)lds); }
                        else { const int v = u - N_CS - N_SWA;
 lru_unit<0>(F, l, v / LRU_CH, v % LRU_CH, INP(7), INP(8), INP(10), INP(12), INP(13));
 }
                    }
    }
    if constexpr (ST == ST_S2) {
                    constexpr int N_FOX = 4 * 8 * 17, N_LRU = 4 * LRU_CH;
                    for (int i = 0;; ++i) { const int u = i * F.G + ((i & 1) ? F.G - 1 - F.bid : F.bid); if (u >= N_FOX) break;
                        const int qb = 16 - u / 32, bh = u % 32, lb = bh >> 3, h = bh & 7;
#ifndef NO_FOX
                        attn_body::attn_unit<8>(lb, h, qb, (const attn_body::bf16*)proj + QF_OFF, (const attn_body::bf16*)proj + KF_OFF, (const attn_body::bf16*)proj + VF_OFF, (attn_body::bf16*)oc + 512,
                                                (const float*)(ws + WS_DK) + (size_t)(lb * 8 + h) * 4352, (char*)lds);
#endif

 }
#ifndef NO_LRUB
                    for (int u = F.G - 1 - F.bid; u < N_LRU; u += F.G) lru_unit<1>(F, l, u / LRU_CH, u % LRU_CH, INP(7), INP(8), INP(10), INP(12), INP(13));
#endif
    }
    if constexpr (ST == ST_S3) {
                    pg8::Gemm g{(const pg8::bf16_t*)oc, (const pg8::bf16_t*)(ws + WS_WB)};
                    typedef pg8::Order<NT_HALF, 4, 3> Ord; Ord S; S.init(F.G, F.bid);
                    pg8::EpiBranch E{(const pg8::bf16_t*)proj, (pg8::bf16_t*)(mg + (size_t)grow0 * DMODEL)};

pg8::gemm_phase<pg8::EpiBranch, Ord, true, true, 512, 1536, 512, 4>(F.lds, g, S, E);
    }
    if constexpr (ST == ST_G4) {
                zero_u64(F, ssqB, MP);
                pg8::Gemm g{(const pg8::bf16_t*)mg, (const pg8::bf16_t*)(ws + WS_WOUT)};
                typedef pg8::Order<129, 4, 1> Ord; Ord S; S.init(F.G, F.bid);
                pg8::EpiRes E{F.out, (float*)(ws + WS_HMETA), (pg8::bf16_t*)hb, ssqA};

pg8::gemm_phase<pg8::EpiRes, Ord, true, true, 1024, 1024, 0, 0>(F.lds, g, S, E);
    }
    if constexpr (ST == ST_G5) {
                pg8::Gemm g{(const pg8::bf16_t*)hb, (const pg8::bf16_t*)(ws + WS_WFFI)};
                typedef pg8::Order<129, 22, 1> Ord; Ord S; S.init(F.G, F.bid);
                pg8::EpiSwiglu E{(pg8::bf16_t*)proj, ssqA};

pg8::gemm_phase<pg8::EpiSwiglu, Ord, true, true, 1024, 1024, 0, 0>(F.lds, g, S, E);
    }
    if constexpr (ST == ST_G6) {
                zero_u64(F, ssqA, MP);
                pg8::Gemm g{(const pg8::bf16_t*)proj, (const pg8::bf16_t*)(ws + WS_WFFO)};
                typedef pg8::Order<129, 4, 1> Ord; Ord S; S.init(F.G, F.bid);
                pg8::EpiRes E{F.out, (float*)(ws + WS_HMETA), (pg8::bf16_t*)hb, ssqB};

pg8::gemm_phase<pg8::EpiRes, Ord, true, true, 2816, 2816, 0, 0>(F.lds, g, S, E);
    }
}
__device__ __forceinline__ void make_frame(Frame& F, const Args& args, unsigned char* lds) {
    F.lds = (LAS unsigned char*)lds; F.tid = threadIdx.x; F.lane = F.tid & 63; F.wave = __builtin_amdgcn_readfirstlane(F.tid >> 6); F.G = gridDim.x; F.bid = blockIdx.x;
    F.out = args.out; F.ws = args.ws;
}
template <int ST> __global__ void __launch_bounds__(NWAVES * 64, 2) k_stage(Args args, int l, int half) {
    extern __shared__ __attribute__((aligned(16))) unsigned char lds[];
    Frame F; make_frame(F, args, lds);
    run_stage<ST>(F, args, lds, l, half);
}
template <int ST> static void launch_stage(const Args& a, int l, int half, int grid, hipStream_t stream) {
    static bool attr = false;
    if (!attr) { (void)hipFuncSetAttribute((const void*)k_stage<ST>, hipFuncAttributeMaxDynamicSharedMemorySize, LDS_BYTES); attr = true; }
    hipLaunchKernelGGL(k_stage<ST>, dim3(grid), dim3(NWAVES * 64), LDS_BYTES, stream, a, l, half);
}
extern "C" void kernel_launch(void* const* d_in, const int* in_sizes, int n_in, void* d_out, int out_size, void* d_ws, size_t ws_size, hipStream_t stream) {
    static int grid = 0;
    if (grid == 0) {
        if (n_in != 20 || out_size != 32768 * 1024 || ws_size < WS_END) { fprintf(stderr, "kernel_launch: unexpected shapes (n_in %d out %d ws %zu need %zu)\n", n_in, out_size, ws_size, (size_t)WS_END); grid = -1; return; }
        int dev = 0, cus = 0;
        (void)hipGetDevice(&dev); (void)hipDeviceGetAttribute(&cus, hipDeviceAttributeMultiprocessorCount, dev);
        grid = cus > 0 ? cus : 256;
    }
    if (grid < 0) return;
    (void)hipMemsetAsync((char*)d_ws + WS_CTL, 0, CTL_ZERO_BYTES, stream);
    Args a{};
    for (int i = 0; i < 20; ++i) a.in[i] = (const float*)d_in[i];
    a.out = (float*)d_out; a.ws = (unsigned char*)d_ws;
#if ONE_LAUNCH
#else
    launch_stage<ST_INIT>(a, 0, 0, grid, stream);
    for (int l = 0; l < 4; ++l) {
        if (l > 0) launch_stage<ST_WCONV>(a, l, 0, grid, stream);
        for (int half = 0; half < 2; ++half) { launch_stage<ST_G1>(a, l, half, grid, stream); launch_stage<ST_S1>(a, l, half, grid, stream); launch_stage<ST_S2>(a, l, half, grid, stream); launch_stage<ST_S3>(a, l, half, grid, stream); }
        launch_stage<ST_G4>(a, l, 0, grid, stream); launch_stage<ST_G5>(a, l, 0, grid, stream); launch_stage<ST_G6>(a, l, 0, grid, stream);
    }
    launch_stage<ST_FINAL>(a, 0, 0, grid, stream);
#endif
}
```

```cpp
#include <hip/hip_runtime.h>
#include <hip/hip_cooperative_groups.h>
#include <cstdio>
#include <cstdint>
__device__ __forceinline__ int otid(int wv) { int w_ = wv; asm volatile("" : "+s"(w_)); int ln; asm volatile("v_mbcnt_lo_u32_b32 %0, -1, 0\n\tv_mbcnt_hi_u32_b32 %0, -1, %0" : "=v"(ln)); __builtin_assume(w_ >= 0 && w_ < 8); __builtin_assume(ln >= 0 && ln < 64); return w_ * 64 + ln; }
__device__ __forceinline__ float bperm_f(int srclane, float v) { return __int_as_float(__builtin_amdgcn_ds_bpermute(srclane << 2, __float_as_int(v))); }
typedef const float* cfp_t;
__device__ __forceinline__ cfp_t karg_ptr(int off) { asm volatile("" : "+s"(off)); const __attribute__((address_space(4))) char* b = (const __attribute__((address_space(4))) char*)__builtin_amdgcn_kernarg_segment_ptr(); return *(const __attribute__((address_space(4))) cfp_t*)(b + off); }
namespace pg8 {
#define PG8_LAS __attribute__((address_space(3)))
typedef unsigned short bf16_t;
typedef short bf16x8 __attribute__((ext_vector_type(8)));
typedef float f32x4 __attribute__((ext_vector_type(4)));
typedef unsigned u32x4 __attribute__((ext_vector_type(4)));
constexpr int BM = 256, BK = 64, HALF = 128, HTB = HALF * BK * 2  , STAGE_BYTES = 8 * HTB, NXCD = 8, WGM = 6;

__host__ __device__ __forceinline__ int lds_byte(int r, int c) { const int st = (r >> 4) * 2 + (c >> 5), rr = r & 15, cc = c & 31, ob = rr * 64 + cc * 2; return st * 1024 + (ob ^ (((ob >> 9) & 1) << 5)); }
__host__ __device__ __forceinline__ void stage_rc(int b, int& R, int& C) { const int st = b / 1024, sb = b % 1024, swz = sb ^ (((sb >> 9) & 1) << 5); R = (st >> 1) * 16 + swz / 64; C = (st & 1) * 32 + (swz % 64) / 2; }
__host__ __device__ __forceinline__ int perm32(int rho) { const int n = rho >> 4, i = rho & 15; return 8 * (i >> 2) + 4 * n + (i & 3); }

struct Unit { int pm, pn, g, part; };
struct Gemm { const bf16_t* A; const bf16_t* Bt; };

template <int nM, int nN, int NG> struct Order {
    static constexpr int nwg = nM * nN;
    int G, c;
    __device__ void init(int G_, int c_) { G = G_; c = c_; }
    __device__ bool next(int i, Unit& u) const {
        const int ti = (NG == 1) ? i : i / NG; u.g = (NG == 1) ? 0 : i - ti * NG; u.part = 0;
        const long L = (long)ti * G + c; if (L >= nwg) return false;
        int wgid = (int)L; { constexpr int q = nwg / NXCD, r = nwg % NXCD; const int xcd = wgid % NXCD, off = wgid / NXCD; wgid = (xcd < r ? xcd * (q + 1) : r * (q + 1) + (xcd - r) * q) + off; }
        constexpr int nig = WGM * nN; const int gid = wgid / nig, fm = gid * WGM, gsz = (nM - fm) < WGM ? (nM - fm) : WGM;
        u.pm = fm + ((wgid % nig) % gsz); u.pn = (wgid % nig) / gsz; return true;
    }
    __device__ __forceinline__ void a_ready(const Unit&) const {}
    __device__ __forceinline__ void done(const Unit&) const {}
};
struct OrderS3 {
    int G, c;
    __device__ void init(int G_, int c_) { G = G_; c = c_; }
    __device__ __forceinline__ bool next(int i, Unit& u) const {
        constexpr int nM = 64, nN = 4, nwg = nM * nN;
        const int nmain = (c < nwg) ? ((nwg - 1 - c) / G + 1) : 0;
        const bool mainu = i < 3 * nmain;
        const int ti = i / 3, gm = i - ti * 3;
        int wgid = ti * G + c; { constexpr int q = nwg / NXCD, r = nwg % NXCD; const int xcd = wgid % NXCD, off = wgid / NXCD; wgid = (xcd < r ? xcd * (q + 1) : r * (q + 1) + (xcd - r) * q) + off; }
        constexpr int nig = WGM * nN; const int gid = wgid / nig, fm = gid * WGM, gsz = (nM - fm) < WGM ? (nM - fm) : WGM;
        const int pm_m = fm + ((wgid % nig) % gsz), pn_m = (wgid % nig) / gsz;
        const int j = (i - 3 * nmain) * G + c, pn_l = j / 3, g_l = j - pn_l * 3;
        u.pm = mainu ? pm_m : 64; u.pn = mainu ? pn_m : pn_l; u.g = mainu ? gm : g_l; u.part = mainu ? 0 : 1;
        return mainu || j < 12;
    }
    __device__ __forceinline__ void a_ready(const Unit&) const {}
    __device__ __forceinline__ void done(const Unit&) const {}
};
template <int NKC> struct OrderTailK {
    int G, c;
    __device__ void init(int G_, int c_) { G = G_; c = c_; }
    __device__ __forceinline__ bool next(int i, Unit& u) const {
        constexpr int nM = 128, nN = 4, nwg = nM * nN;
        const int nmain = (c < nwg) ? ((nwg - 1 - c) / G + 1) : 0;
        const bool mainu = i < nmain;
        int wgid = i * G + c; { constexpr int q = nwg / NXCD, r = nwg % NXCD; const int xcd = wgid % NXCD, off = wgid / NXCD; wgid = (xcd < r ? xcd * (q + 1) : r * (q + 1) + (xcd - r) * q) + off; }
        constexpr int nig = WGM * nN; const int gid = wgid / nig, fm = gid * WGM, gsz = (nM - fm) < WGM ? (nM - fm) : WGM;
        const int pm_m = fm + ((wgid % nig) % gsz), pn_m = (wgid % nig) / gsz;
        const int j = (i - nmain) * G + c, pn_l = j / NKC, g_l = j - pn_l * NKC;
        u.pm = mainu ? pm_m : 128; u.pn = mainu ? pn_m : pn_l; u.g = mainu ? 0 : g_l; u.part = mainu ? 0 : 1;
        return mainu || j < 4 * NKC;
    }
    __device__ __forceinline__ void a_ready(const Unit&) const {}
    __device__ __forceinline__ void done(const Unit&) const {}
};
__device__ __forceinline__ unsigned cvt_pk_bf16(float lo, float hi) { unsigned r; asm volatile("v_cvt_pk_bf16_f32 %0, %1, %2" : "=v"(r) : "v"(lo), "v"(hi)); return r; }
__device__ __forceinline__ float bf_lo(unsigned w) { return __uint_as_float(w << 16); }
__device__ __forceinline__ float bf_hi(unsigned w) { return __uint_as_float(w & 0xffff0000u); }
__device__ __forceinline__ float sigmoid_f(float x) { return __builtin_amdgcn_rcpf(1.f + __expf(-x)); }
constexpr int M_TOK = 32896, T_TOK = 4112, NPROJ = 6656, GATE_OFF = 3328, DFF = 2816, DM = 1024, FL_LD = 16896;

#define PG8_PIN4(a, b, c, d) asm volatile("" :: "v"(a), "v"(b), "v"(c), "v"(d))
__device__ __forceinline__ float rs_of(unsigned long long q) { return rsqrtf((float)q * (1.0f / (1024.0f * 1048576.0f)) + 1e-6f); }
struct EpiProj {
    static constexpr bool PERM = true, AFTER_DRAIN = false;
    bf16_t* P; float* fl; const unsigned long long* ssq; int grow0;
    __device__ __forceinline__ void operator()(const f32x4 (&acc)[2][2][4][2], const Unit& u, int wr, int wc, int fr, int fq) const {
        const int row0 = u.pm * BM + wr * 64 + fr, col0 = u.pn * BM + wc * 32 + 8 * fq;
        unsigned long long q[2][4];
#pragma unroll
        for (int ai = 0; ai < 2; ++ai)
#pragma unroll
            for (int m = 0; m < 4; ++m) { const int grow = row0 + ai * HALF + m * 16 + grow0; q[ai][m] = ssq[grow < M_TOK ? grow : M_TOK - 1]; }
        PG8_PIN4(q[0][0], q[0][1], q[0][2], q[0][3]); PG8_PIN4(q[1][0], q[1][1], q[1][2], q[1][3]);
#pragma unroll
        for (int ai = 0; ai < 2; ++ai)
#pragma unroll
            for (int m = 0; m < 4; ++m) { const int lrow = row0 + ai * HALF + m * 16, grow = lrow + grow0;
                const float s = (grow < M_TOK) ? rs_of(q[ai][m]) : 0.f;
                if (u.pn < 25) {
#pragma unroll
                    for (int bj = 0; bj < 2; ++bj) { const f32x4 v0 = acc[ai][bj][m][0] * s, v1 = acc[ai][bj][m][1] * s;
                        u32x4 w; w.x = cvt_pk_bf16(v0[0], v0[1]); w.y = cvt_pk_bf16(v0[2], v0[3]); w.z = cvt_pk_bf16(v1[0], v1[1]); w.w = cvt_pk_bf16(v1[2], v1[3]);
                        *(u32x4*)(P + (size_t)lrow * NPROJ + col0 + bj * HALF) = w; }
                } else if (wc == 0 && fq == 0) {
                    *(f32x4*)(fl + (size_t)lrow * 8) = acc[ai][0][m][0] * s; *(f32x4*)(fl + (size_t)lrow * 8 + 4) = acc[ai][0][m][1] * s; }
            }
    }
};
struct EpiBranch {
    static constexpr bool PERM = true, AFTER_DRAIN = false;
    const bf16_t* P; bf16_t* MG; bf16_t* PART;
    __device__ __forceinline__ void operator()(const f32x4 (&acc)[2][2][4][2], const Unit& u, int wr, int wc, int fr, int fq) const {
        const int row0 = u.pm * BM + wr * 64 + fr, col0 = u.pn * BM + wc * 32 + 8 * fq;
#pragma unroll
        for (int ai = 0; ai < 2; ++ai) {
            if (u.part && (ai != 0 || wr != 0)) continue;
            u32x4 gw[4][2], pw[4][2];
#pragma unroll
            for (int m = 0; m < 4; ++m)
#pragma unroll
                for (int bj = 0; bj < 2; ++bj) { const int lrow = row0 + ai * HALF + m * 16, c = col0 + bj * HALF;
                    gw[m][bj] = *(const u32x4*)(P + (size_t)lrow * NPROJ + GATE_OFF + u.g * DM + c);
                    const u32x4 pv_ = *(const u32x4*)(MG + (size_t)lrow * DM + c);
                    pw[m][bj] = (u.g > 0 && !u.part) ? pv_ : (u32x4){0u, 0u, 0u, 0u}; }
            PG8_PIN4(gw[0][0], gw[0][1], gw[1][0], gw[1][1]); PG8_PIN4(gw[2][0], gw[2][1], gw[3][0], gw[3][1]);
            PG8_PIN4(pw[0][0], pw[0][1], pw[1][0], pw[1][1]); PG8_PIN4(pw[2][0], pw[2][1], pw[3][0], pw[3][1]);
#pragma unroll
            for (int m = 0; m < 4; ++m)
#pragma unroll
                for (int bj = 0; bj < 2; ++bj) { const int lrow = row0 + ai * HALF + m * 16, c = col0 + bj * HALF; const u32x4 g4 = gw[m][bj], p4 = pw[m][bj];
                    f32x4 v0 = acc[ai][bj][m][0], v1 = acc[ai][bj][m][1];
                    v0[0] = v0[0] * sigmoid_f(bf_lo(g4.x)) + bf_lo(p4.x); v0[1] = v0[1] * sigmoid_f(bf_hi(g4.x)) + bf_hi(p4.x); v0[2] = v0[2] * sigmoid_f(bf_lo(g4.y)) + bf_lo(p4.y); v0[3] = v0[3] * sigmoid_f(bf_hi(g4.y)) + bf_hi(p4.y);
                    v1[0] = v1[0] * sigmoid_f(bf_lo(g4.z)) + bf_lo(p4.z); v1[1] = v1[1] * sigmoid_f(bf_hi(g4.z)) + bf_hi(p4.z); v1[2] = v1[2] * sigmoid_f(bf_lo(g4.w)) + bf_lo(p4.w); v1[3] = v1[3] * sigmoid_f(bf_hi(g4.w)) + bf_hi(p4.w);
                    u32x4 w; w.x = cvt_pk_bf16(v0[0], v0[1]); w.y = cvt_pk_bf16(v0[2], v0[3]); w.z = cvt_pk_bf16(v1[0], v1[1]); w.w = cvt_pk_bf16(v1[2], v1[3]);
                    bf16_t* dst = u.part ? PART + ((size_t)u.g * 64 + (lrow - 64 * BM)) * DM + c : MG + (size_t)lrow * DM + c;
                    *(u32x4*)dst = w; }
        }
    }
};
struct EpiRes {
    static constexpr bool PERM = true, AFTER_DRAIN = false;
    float* hout; float* hmeta; bf16_t* hb; unsigned long long* ssq; float* partk; float mul;
    __device__ __forceinline__ void operator()(const f32x4 (&acc)[2][2][4][2], const Unit& u, int wr, int wc, int fr, int fq) const {
        const int row0 = u.pm * BM + wr * 64 + fr, col0 = u.pn * BM + wc * 32 + 8 * fq;
        if (u.part) {
            float* pp = partk + ((size_t)u.g * 128 + wr * 64 + fr) * DM + col0;
#pragma unroll
            for (int m = 0; m < 4; ++m)
#pragma unroll
                for (int bj = 0; bj < 2; ++bj)
#pragma unroll
                    for (int n = 0; n < 2; ++n) *(f32x4*)(pp + (size_t)m * 16 * DM + bj * HALF + n * 4) = acc[0][bj][m][n];
        } else
#pragma unroll
        for (int ai = 0; ai < 2; ++ai) {
            f32x4 hv[4][2][2]; float* hp0, *hp1, *hp2, *hp3;
#pragma unroll
            for (int m = 0; m < 4; ++m) { int grow = row0 + ai * HALF + m * 16; grow = grow < M_TOK ? grow : M_TOK - 1; const int b = grow / T_TOK, t = grow - b * T_TOK;
                float* hpm = ((t < 16) ? hmeta + (size_t)(b * 16 + t) * DM : hout + ((size_t)b * 4096 + (t - 16)) * DM) + col0;
                if (m == 0) hp0 = hpm; else if (m == 1) hp1 = hpm; else if (m == 2) hp2 = hpm; else hp3 = hpm;
#pragma unroll
                for (int bj = 0; bj < 2; ++bj)
#pragma unroll
                    for (int n = 0; n < 2; ++n) hv[m][bj][n] = *(const f32x4*)(hpm + bj * HALF + n * 4); }
#pragma unroll
            for (int m = 0; m < 4; ++m) PG8_PIN4(hv[m][0][0], hv[m][0][1], hv[m][1][0], hv[m][1][1]);
#pragma unroll
            for (int m = 0; m < 4; ++m) { const int grow = row0 + ai * HALF + m * 16; const bool ok = grow < M_TOK; float ss = 0.f; float* hpm = (m == 0) ? hp0 : (m == 1) ? hp1 : (m == 2) ? hp2 : hp3;
#pragma unroll
                for (int bj = 0; bj < 2; ++bj) { const f32x4 o0 = hv[m][bj][0] + acc[ai][bj][m][0] * mul, o1 = hv[m][bj][1] + acc[ai][bj][m][1] * mul;
                    ss += (o0[0] * o0[0] + o0[1] * o0[1]) + (o0[2] * o0[2] + o0[3] * o0[3]) + (o1[0] * o1[0] + o1[1] * o1[1]) + (o1[2] * o1[2] + o1[3] * o1[3]);
                    u32x4 w; w.x = cvt_pk_bf16(o0[0], o0[1]); w.y = cvt_pk_bf16(o0[2], o0[3]); w.z = cvt_pk_bf16(o1[0], o1[1]); w.w = cvt_pk_bf16(o1[2], o1[3]);
                    if (ok) { *(f32x4*)(hpm + bj * HALF) = o0; *(f32x4*)(hpm + bj * HALF + 4) = o1; *(u32x4*)(hb + (size_t)grow * DM + col0 + bj * HALF) = w; } }
                { const int ln_ = fq * 16 + fr; ss += bperm_f(ln_ ^ 16, ss); ss += bperm_f(ln_ ^ 32, ss); }
                if (fq == 0 && ok) atomicAdd(ssq + grow, (unsigned long long)(ss * (1048576.0f * mul)));
            }
        }
    }
};
struct EpiSwiglu {
    static constexpr bool PERM = true, AFTER_DRAIN = false;
    bf16_t* ACT; const unsigned long long* ssq;
    __device__ __forceinline__ void operator()(const f32x4 (&acc)[2][2][4][2], const Unit& u, int wr, int wc, int fr, int fq) const {
        const int row0 = u.pm * BM + wr * 64 + fr, col0 = u.pn * HALF + wc * 32 + 8 * fq;
        unsigned long long q[2][4];
#pragma unroll
        for (int ai = 0; ai < 2; ++ai)
#pragma unroll
            for (int m = 0; m < 4; ++m) { const int grow = row0 + ai * HALF + m * 16; q[ai][m] = ssq[grow < M_TOK ? grow : M_TOK - 1]; }
        PG8_PIN4(q[0][0], q[0][1], q[0][2], q[0][3]); PG8_PIN4(q[1][0], q[1][1], q[1][2], q[1][3]);
#pragma unroll
        for (int ai = 0; ai < 2; ++ai)
#pragma unroll
            for (int m = 0; m < 4; ++m) { const int grow = row0 + ai * HALF + m * 16;
                const float s = (grow < M_TOK) ? rs_of(q[ai][m]) : 0.f;
                float o[8];
#pragma unroll
                for (int n = 0; n < 2; ++n)
#pragma unroll
                    for (int j = 0; j < 4; ++j) { const float gt = acc[ai][0][m][n][j] * s, up = acc[ai][1][m][n][j] * s; o[4 * n + j] = gt * sigmoid_f(gt) * up; }
                u32x4 w; w.x = cvt_pk_bf16(o[0], o[1]); w.y = cvt_pk_bf16(o[2], o[3]); w.z = cvt_pk_bf16(o[4], o[5]); w.w = cvt_pk_bf16(o[6], o[7]);
                *(u32x4*)(ACT + (size_t)grow * DFF + col0) = w; }
    }
};

template <class Epi, class Sched, bool ALIGN_EPI, bool SP2, int GK, int LDA, int AGOFF, int BGT, int KC = 0>
__device__ __forceinline__ void gemm_phase(PG8_LAS unsigned char* lds, const Gemm g, const Sched& S, const Epi& E, int wv) {
    const int tid = otid(wv), wid = __builtin_amdgcn_readfirstlane(tid >> 6), lane = tid & 63, wr = wid >> 2, wc = wid & 3, fr = lane & 15, fq = lane >> 4;
    constexpr int K = GK, nt = K / BK;
    unsigned voffA[2], voffB[2];
#pragma unroll
    for (int i = 0; i < 2; ++i) { int R, C; stage_rc(tid * 16 + i * 8192, R, C); const int Rb = Epi::PERM ? ((R & ~31) + perm32(R & 31)) : R;
        voffA[i] = (unsigned)(R * LDA + C) * 2u; voffB[i] = (unsigned)(Rb * K + C) * 2u; }
    constexpr size_t kstep = (size_t)(BK * 2);
    constexpr size_t hstepA = (size_t)HALF * LDA * 2, hstepB = (size_t)HALF * K * 2;
    constexpr size_t tstepA = 2 * hstepA, tstepB = 2 * hstepB;
    const unsigned ldsw = (unsigned)wid * 1024u;
    const int aoff = lds_byte(wr * 64 + fr, fq * 8), boff = lds_byte(wc * 32 + fr, fq * 8);
#define PG8_SA(b, h) (((b) * 2 + (h)) * HTB)
#define PG8_SB(b, h) ((4 + (b) * 2 + (h)) * HTB)
#define PG8_STAGE(bufoff, gbase, voff) do { _Pragma("unroll") for (int _i = 0; _i < 2; ++_i) \
        __builtin_amdgcn_global_load_lds((const unsigned*)((const char*)(gbase) + (voff)[_i]), (PG8_LAS unsigned*)(lds + (bufoff) + ldsw + _i * 8192), 16, 0, 0); } while (0)
#define PG8_LDA(dst, b, h) do { _Pragma("unroll") for (int m = 0; m < 4; ++m) _Pragma("unroll") for (int k = 0; k < 2; ++k) dst[m][k] = *(const PG8_LAS bf16x8*)(lds + PG8_SA(b, h) + aoff + m * 2048 + k * 1024); } while (0)
#define PG8_LDB(dst, b, h) do { _Pragma("unroll") for (int n = 0; n < 2; ++n) _Pragma("unroll") for (int k = 0; k < 2; ++k) dst[n][k] = *(const PG8_LAS bf16x8*)(lds + PG8_SB(b, h) + boff + n * 2048 + k * 1024); } while (0)
#define PG8_MMA(ai, bj, At, Bt) do { __builtin_amdgcn_s_setprio(1); _Pragma("unroll") for (int m = 0; m < 4; ++m) _Pragma("unroll") for (int n = 0; n < 2; ++n) _Pragma("unroll") for (int k = 0; k < 2; ++k) \
        acc[ai][bj][m][n] = __builtin_amdgcn_mfma_f32_16x16x32_bf16(Bt[n][k], At[m][k], acc[ai][bj][m][n], 0, 0, 0); __builtin_amdgcn_s_setprio(0); } while (0)
#define PG8_WAIT_V(n) asm volatile("s_waitcnt vmcnt(" #n ")" ::: "memory")
#define PG8_WAIT_L(n) asm volatile("s_waitcnt lgkmcnt(" #n ")" ::: "memory")
#define PG8_BAR __builtin_amdgcn_s_barrier()
#define PG8_SCHED __builtin_amdgcn_sched_barrier(0)
    Unit cur, nxt; int ui = 0;
    if (!S.next(0, cur)) return;
    f32x4 acc[2][2][4][2];
#pragma unroll
    for (int a = 0; a < 2; ++a)
#pragma unroll
        for (int b = 0; b < 2; ++b)
#pragma unroll
            for (int m = 0; m < 4; ++m)
#pragma unroll
                for (int n = 0; n < 2; ++n) acc[a][b][m][n] = (f32x4){0.f, 0.f, 0.f, 0.f};
    bf16x8 At[4][2], B0[2][2], B1[2][2];
    const char* cA = (const char*)g.A + (size_t)cur.pm * tstepA + (size_t)cur.g * AGOFF * 2 + ((KC && cur.part) ? cur.g * (KC * 2) : 0); const char* cB = (const char*)g.Bt + (size_t)(cur.pn + cur.g * BGT) * tstepB + ((KC && cur.part) ? cur.g * (KC * 2) : 0);
    S.a_ready(cur);
    if constexpr (SP2) {
        PG8_STAGE(PG8_SB(0, 0), cB, voffB); PG8_STAGE(PG8_SB(0, 1), cB + hstepB, voffB); PG8_STAGE(PG8_SA(0, 0), cA, voffA); PG8_STAGE(PG8_SA(0, 1), cA + hstepA, voffA);
        if (wr == 1) PG8_BAR;
        PG8_WAIT_V(2); PG8_BAR;
        PG8_STAGE(PG8_SB(1, 0), cB + kstep, voffB); PG8_STAGE(PG8_SA(1, 0), cA + kstep, voffA); PG8_STAGE(PG8_SB(1, 1), cB + hstepB + kstep, voffB);
        PG8_WAIT_V(6); PG8_BAR;
    } else {
        PG8_STAGE(PG8_SB(0, 0), cB, voffB); PG8_STAGE(PG8_SA(0, 0), cA, voffA); PG8_STAGE(PG8_SB(0, 1), cB + hstepB, voffB); PG8_STAGE(PG8_SA(0, 1), cA + hstepA, voffA);
        if (wr == 1) PG8_BAR;
        PG8_WAIT_V(4); PG8_BAR;
        PG8_STAGE(PG8_SB(1, 0), cB + kstep, voffB); PG8_STAGE(PG8_SA(1, 0), cA + kstep, voffA); PG8_STAGE(PG8_SB(1, 1), cB + hstepB + kstep, voffB);
        PG8_WAIT_V(6); PG8_BAR;
    }
    for (;;) {
        const bool has_next = S.next(ui + 1, nxt);
        const char* nA = has_next ? (const char*)g.A + (size_t)nxt.pm * tstepA + (size_t)nxt.g * AGOFF * 2 + ((KC && nxt.part) ? nxt.g * (KC * 2) : 0) : cA; const char* nB = has_next ? (const char*)g.Bt + (size_t)(nxt.pn + nxt.g * BGT) * tstepB + ((KC && nxt.part) ? nxt.g * (KC * 2) : 0) : cB;
        const int ntu = (KC && cur.part) ? KC / BK : nt;
        for (int t = 0; t < ntu; t += 2) {
            const bool last = (t == ntu - 2);
            const char* a1 = cA + (size_t)(t + 1) * kstep;
            const char* a2 = last ? nA : cA + (size_t)(t + 2) * kstep; const char* b2 = last ? nB : cB + (size_t)(t + 2) * kstep;
            const char* a3 = a2 + kstep; const char* b3 = b2 + kstep;
            if (last && has_next) S.a_ready(nxt);
            if constexpr (SP2) {
            PG8_LDB(B0, 0, 0); PG8_LDB(B1, 0, 1); PG8_SCHED; PG8_LDA(At, 0, 0); PG8_STAGE(PG8_SA(1, 1), a1 + hstepA, voffA);
            PG8_WAIT_V(8); PG8_WAIT_L(0); PG8_BAR; PG8_MMA(0, 0, At, B0); PG8_MMA(0, 1, At, B1); PG8_BAR; PG8_SCHED;
            PG8_LDA(At, 0, 1); PG8_STAGE(PG8_SB(0, 0), b2, voffB); PG8_STAGE(PG8_SB(0, 1), b2 + hstepB, voffB); PG8_STAGE(PG8_SA(0, 0), a2, voffA);
            PG8_WAIT_V(8); PG8_WAIT_L(0); PG8_BAR; PG8_MMA(1, 0, At, B0); PG8_MMA(1, 1, At, B1); PG8_BAR; PG8_SCHED;
            PG8_LDB(B0, 1, 0); PG8_LDB(B1, 1, 1); PG8_SCHED; PG8_LDA(At, 1, 0); PG8_STAGE(PG8_SA(0, 1), a2 + hstepA, voffA);
            PG8_WAIT_V(8); PG8_WAIT_L(0); PG8_BAR; PG8_MMA(0, 0, At, B0); PG8_MMA(0, 1, At, B1); PG8_BAR; PG8_SCHED;
            PG8_LDA(At, 1, 1); PG8_STAGE(PG8_SB(1, 0), b3, voffB); PG8_STAGE(PG8_SB(1, 1), b3 + hstepB, voffB); PG8_STAGE(PG8_SA(1, 0), a3, voffA);
            PG8_WAIT_V(8); PG8_WAIT_L(0); PG8_BAR; PG8_MMA(1, 0, At, B0); PG8_MMA(1, 1, At, B1); PG8_BAR; PG8_SCHED;
            } else {
            PG8_LDB(B0, 0, 0); PG8_SCHED; PG8_LDA(At, 0, 0); PG8_STAGE(PG8_SA(1, 1), a1 + hstepA, voffA);
            PG8_WAIT_L(8); PG8_BAR; PG8_WAIT_L(0); PG8_MMA(0, 0, At, B0); PG8_BAR; PG8_SCHED;
            PG8_LDB(B1, 0, 1); PG8_STAGE(PG8_SB(0, 0), b2, voffB);
            PG8_BAR; PG8_WAIT_L(0); PG8_MMA(0, 1, At, B1); PG8_BAR;
            PG8_LDA(At, 0, 1); PG8_STAGE(PG8_SA(0, 0), a2, voffA);
            PG8_BAR; PG8_WAIT_L(0); PG8_MMA(1, 0, At, B0); PG8_BAR; PG8_SCHED;
            PG8_STAGE(PG8_SB(0, 1), b2 + hstepB, voffB);
            PG8_WAIT_V(6); PG8_BAR; PG8_MMA(1, 1, At, B1); PG8_BAR;
            PG8_LDB(B0, 1, 0); PG8_SCHED; PG8_LDA(At, 1, 0); PG8_STAGE(PG8_SA(0, 1), a2 + hstepA, voffA);
            PG8_WAIT_L(8); PG8_BAR; PG8_WAIT_L(0); PG8_MMA(0, 0, At, B0); PG8_BAR; PG8_SCHED;
            PG8_LDB(B1, 1, 1); PG8_STAGE(PG8_SB(1, 0), b3, voffB);
            PG8_BAR; PG8_WAIT_L(0); PG8_MMA(0, 1, At, B1); PG8_BAR;
            PG8_LDA(At, 1, 1); PG8_STAGE(PG8_SA(1, 0), a3, voffA);
            PG8_BAR; PG8_WAIT_L(0); PG8_MMA(1, 0, At, B0); PG8_BAR; PG8_SCHED;
            PG8_STAGE(PG8_SB(1, 1), b3 + hstepB, voffB);
            PG8_WAIT_V(6); PG8_BAR; PG8_MMA(1, 1, At, B1); PG8_BAR;
            }
        }
        if constexpr (ALIGN_EPI) { if (wr == 0) PG8_BAR; }
        if constexpr (!Epi::AFTER_DRAIN) { E(acc, cur, wr, wc, fr, fq); S.done(cur); }
        if (!has_next) break;
#pragma unroll
        for (int a = 0; a < 2; ++a)
#pragma unroll
            for (int b = 0; b < 2; ++b)
#pragma unroll
                for (int m = 0; m < 4; ++m)
#pragma unroll
                    for (int n = 0; n < 2; ++n) acc[a][b][m][n] = (f32x4){0.f, 0.f, 0.f, 0.f};
        cur = nxt; cA = nA; cB = nB; ++ui;
        if constexpr (ALIGN_EPI) { if (wr == 1) PG8_BAR; }
    }
    PG8_WAIT_V(0);
    if constexpr (!ALIGN_EPI) { if (wr == 0) PG8_BAR; }
    PG8_BAR;
    if constexpr (Epi::AFTER_DRAIN) { E.fused(acc, cur, wr, wc, fr, fq, lds, wid, lane); S.done(cur); }
#undef PG8_SA
#undef PG8_SB
#undef PG8_STAGE
#undef PG8_LDA
#undef PG8_LDB
#undef PG8_MMA
#undef PG8_WAIT_V
#undef PG8_WAIT_L
#undef PG8_BAR
#undef PG8_SCHED
}
}

#include <hip/hip_bf16.h>
#include <cmath>
namespace attn_body {
using bf16=__hip_bfloat16;
using bf16x8=__attribute__((ext_vector_type(8)))short;
using s16x4=__attribute__((ext_vector_type(4)))short;
using f32x16=__attribute__((ext_vector_type(16)))float;
using u32x4=__attribute__((ext_vector_type(4)))unsigned;
constexpr int D=64,PQ=6656,PO=1536,TTOK=4112;
constexpr int NW=8,QBLK=32,QB=QBLK*NW,KVBLK=64,NQB=17;
__device__ __forceinline__ int crow(int r,int hi){return (r&3)+8*(r>>2)+4*hi;}
#define SBAR() __builtin_amdgcn_sched_barrier(0)
__device__ __forceinline__ void cmask(f32x16&p0,f32x16&p1,int jb,int qrel,int hi){
  const float NEG=-INFINITY; int kb=64*jb+4*hi;
  #pragma unroll
  for(int r=0;r<16;++r){int kv=kb+(r&3)+8*(r>>2); if(kv>qrel)p0[r]=NEG; if(kv+32>qrel)p1[r]=NEG;}
}

constexpr int NSLOT=3, SLOTB=8192;
constexpr int LDS_K=0, LDS_V=NSLOT*SLOTB, LDS_WS=2*NSLOT*SLOTB, LDS_OST=LDS_WS+NW*64*4, LDS_BYTES=LDS_OST+NW*4096, LDS_DK=LDS_BYTES, LDS_END=LDS_DK+66*256;
constexpr float C2=0.125f*1.4426950408889634f;
__device__ __forceinline__ void glds16(const void*gsrc,unsigned lds_dst){unsigned keep;
  asm volatile("s_mov_b32 %0, m0\n\ts_mov_b32 m0, %2\n\ts_nop 0\n\tglobal_load_lds_dwordx4 %1, off\n\ts_mov_b32 m0, %0":"=&s"(keep):"v"(gsrc),"s"(lds_dst):"memory");}
__device__ __forceinline__ float max3f(float a,float b,float c){float r;asm("v_max3_f32 %0, %1, %2, %3":"=v"(r):"v"(a),"v"(b),"v"(c));return r;}
__device__ __forceinline__ float max2f(float a,float b){float r;asm("v_max_f32_e32 %0, %1, %2":"=v"(r):"v"(a),"v"(b));return r;}
__device__ __forceinline__ float fadd_s(float a,float b){float r;asm("v_add_f32_e32 %0, %1, %2":"=v"(r):"v"(a),"v"(b));return r;}
__device__ __forceinline__ float fsub_s(float a,float b){float r;asm("v_sub_f32_e32 %0, %1, %2":"=v"(r):"v"(a),"v"(b));return r;}
typedef float f32x2_t __attribute__((ext_vector_type(2))); typedef __bf16 bf16x2_t __attribute__((ext_vector_type(2)));
__device__ __forceinline__ unsigned cvtpk_s(float lo,float hi){f32x2_t v={lo,hi};bf16x2_t b=__builtin_convertvector(v,bf16x2_t);return __builtin_bit_cast(unsigned,b);}
#define WAIT_BAR(N) asm volatile("s_waitcnt vmcnt(" #N ") lgkmcnt(0)\n\ts_barrier":::"memory")

__device__ __forceinline__ void qkt(f32x16&p0,f32x16&p1,const char*Kslot,const bf16x8*qr,const f32x16&negm,int r32,int hi){
  const char*kb=Kslot+hi*1024+r32*16;
  #pragma unroll
  for(int d0=0;d0<4;++d0){
    const bf16x8 b0=*reinterpret_cast<const bf16x8*>(kb+d0*2048);
    const bf16x8 b1=*reinterpret_cast<const bf16x8*>(kb+d0*2048+512);
    if(d0==0){p0=__builtin_amdgcn_mfma_f32_32x32x16_bf16(b0,qr[0],negm,0,0,0);p1=__builtin_amdgcn_mfma_f32_32x32x16_bf16(b1,qr[0],negm,0,0,0);}
    else{p0=__builtin_amdgcn_mfma_f32_32x32x16_bf16(b0,qr[d0],p0,0,0,0);p1=__builtin_amdgcn_mfma_f32_32x32x16_bf16(b1,qr[d0],p1,0,0,0);}}
}
typedef __attribute__((address_space(3))) const char* lds_cptr;
typedef short v4i16_t __attribute__((ext_vector_type(4)));
__device__ __forceinline__ void kload8(bf16x8*kf,lds_cptr kp){
  kf[0]=*(const __attribute__((address_space(3))) bf16x8*)(kp);      kf[1]=*(const __attribute__((address_space(3))) bf16x8*)(kp+512);
  kf[2]=*(const __attribute__((address_space(3))) bf16x8*)(kp+2048); kf[3]=*(const __attribute__((address_space(3))) bf16x8*)(kp+2560);
  kf[4]=*(const __attribute__((address_space(3))) bf16x8*)(kp+4096); kf[5]=*(const __attribute__((address_space(3))) bf16x8*)(kp+4608);
  kf[6]=*(const __attribute__((address_space(3))) bf16x8*)(kp+6144); kf[7]=*(const __attribute__((address_space(3))) bf16x8*)(kp+6656);
}
__device__ __forceinline__ void kload2(bf16x8*kf,lds_cptr kp,int j){ kf[2*j]=*(const __attribute__((address_space(3))) bf16x8*)(kp+j*2048); kf[2*j+1]=*(const __attribute__((address_space(3))) bf16x8*)(kp+j*2048+512); }
__device__ __forceinline__ s16x4 vtr(lds_cptr p){ return __builtin_bit_cast(s16x4,__builtin_amdgcn_ds_read_tr16_b64_v4i16((__attribute__((address_space(3))) v4i16_t*)p)); }
__device__ __forceinline__ float rowmax(const f32x16&p0,const f32x16&p1){
  float a=max3f(p0[0],p0[1],p1[0]),b=max3f(p0[2],p0[3],p1[1]);a=max3f(a,p1[2],p1[3]);
  #pragma unroll
  for(int r=4;r<16;r+=4){a=max3f(a,p0[r],p0[r+1]);b=max3f(b,p0[r+2],p0[r+3]);a=max3f(a,p1[r],p1[r+1]);b=max3f(b,p1[r+2],p1[r+3]);}
  const float m=max2f(a,b);
  auto rr=__builtin_amdgcn_permlane32_swap(__float_as_uint(m),__float_as_uint(m),false,false);
  return max2f(__uint_as_float(rr[0]),__uint_as_float(rr[1]));
}
__device__ __forceinline__ void pv(f32x16*o,int vb,bf16x8 pa0,bf16x8 pa1,bf16x8 pa2,bf16x8 pa3){
  #pragma unroll
  for(int d0=0;d0<2;++d0){s16x4 lo[4],hi[4];
    #pragma unroll
    for(int ks=0;ks<4;++ks){
      asm volatile("ds_read_b64_tr_b16 %0,%1 offset:%c2":"=&v"(lo[ks]):"v"(vb),"i"(d0*4096+ks*1024):"memory");
      asm volatile("ds_read_b64_tr_b16 %0,%1 offset:%c2":"=&v"(hi[ks]):"v"(vb),"i"(d0*4096+ks*1024+512):"memory");}
    asm volatile("s_waitcnt lgkmcnt(0)":::"memory");SBAR();
    #define PK(k) (bf16x8){lo[k][0],lo[k][1],lo[k][2],lo[k][3],hi[k][0],hi[k][1],hi[k][2],hi[k][3]}
    o[d0]=__builtin_amdgcn_mfma_f32_32x32x16_bf16(pa0,PK(0),o[d0],0,0,0);
    o[d0]=__builtin_amdgcn_mfma_f32_32x32x16_bf16(pa1,PK(1),o[d0],0,0,0);
    o[d0]=__builtin_amdgcn_mfma_f32_32x32x16_bf16(pa2,PK(2),o[d0],0,0,0);
    o[d0]=__builtin_amdgcn_mfma_f32_32x32x16_bf16(pa3,PK(3),o[d0],0,0,0);
    #undef PK
  }
}

#ifndef ATTN_STORE16
#define ATTN_STORE16(p,v) (*(u32x4*)(p)=(v))
#endif
template<int THRL> __device__ __forceinline__ void attn_unit(int b,int h,int qb,const bf16*Q,const bf16*__restrict__ K,const bf16*__restrict__ V,bf16*O,const float*__restrict__ dkg,char*shm,int wv){
  const int tid=otid(wv),lane=tid&63,r32=lane&31,hi=lane>>5; const int wid=__builtin_amdgcn_readfirstlane(tid>>6);
  const long rowbase=(long)b*TTOK; const int q0=qb*QB;
  const bf16*Qw=Q+(rowbase+q0+wid*QBLK)*PQ+h*D;
  const bf16*Kh=K+rowbase*PQ+h*D,*Vh=V+rowbase*PQ+h*D;
  const unsigned lds0=(unsigned)(uintptr_t)shm;
  float*wsf=(float*)(shm+LDS_WS)+wid*64;
  const bf16*ksrc=Kh+(long)lane*PQ+wid*8;
  const bf16*vsrc=Vh+(long)(16*(wid&3)+(lane>>2))*PQ+(wid>>2)*32+(lane&3)*8;
  const unsigned kdst=lds0+LDS_K+wid*1024, vdst=lds0+LDS_V+wid*1024;
  #define DMA_K(t,slot) glds16(ksrc+(long)(t)*KVBLK*PQ,(unsigned)__builtin_amdgcn_readfirstlane(kdst+(slot)))
  #define DMA_V(t,slot) glds16(vsrc+(long)(t)*KVBLK*PQ,(unsigned)__builtin_amdgcn_readfirstlane(vdst+(slot)))
  const int vb0=(int)(lds0+LDS_V)+((lane>>4)&1)*32+(lane&3)*8+(4*hi+((lane&15)>>2))*64;
  const char*Kbase=shm+LDS_K; bf16x8 kf[8];
  const lds_cptr shm3=(lds_cptr)shm; const lds_cptr kp0=shm3+LDS_K+hi*1024+r32*16; const lds_cptr vp0=shm3+LDS_V+((lane>>4)&1)*32+(lane&3)*8+(4*hi+((lane&15)>>2))*64;
  const int NT=(qb==NQB-1)?66:(q0+QB)/KVBLK; const int band0=4*qb;
  { typedef float f4_t __attribute__((ext_vector_type(4)));
    for(int i_=tid;i_<NT*16;i_+=NW*64){ const f4_t v_=*(const f4_t*)(dkg+4*i_); *(__attribute__((address_space(3))) f4_t*)(shm3+LDS_DK+16*i_)=v_; } }
  #define ADDK(P0,P1,t) do{ typedef float f4_t __attribute__((ext_vector_type(4))); const __attribute__((address_space(3))) f4_t* dq_=(const __attribute__((address_space(3))) f4_t*)(shm3+LDS_DK+(t)*256+hi*16); \
    _Pragma("unroll") for(int g_=0;g_<4;++g_){ const f4_t a_=dq_[2*g_]-mhat, b_=dq_[8+2*g_]-mhat; \
      P0[4*g_]+=a_[0];P0[4*g_+1]+=a_[1];P0[4*g_+2]+=a_[2];P0[4*g_+3]+=a_[3]; P1[4*g_]+=b_[0];P1[4*g_+1]+=b_[1];P1[4*g_+2]+=b_[2];P1[4*g_+3]+=b_[3]; } }while(0)
  DMA_K(0,0);DMA_V(0,0);DMA_K(1,SLOTB);
  bf16x8 qr[4];
  #pragma unroll
  for(int d0=0;d0<4;++d0)qr[d0]=*reinterpret_cast<const bf16x8*>(&Qw[(long)r32*PQ+d0*16+hi*8]);
  const lds_cptr qpark=shm3+LDS_OST+wid*4096+lane*16;
  #pragma unroll
  for(int d0=0;d0<4;++d0)*(__attribute__((address_space(3))) bf16x8*)(qpark+d0*1024)=qr[d0];
  #define QP(k) (*(const __attribute__((address_space(3))) bf16x8*)(qpark+(k)*1024))
  float mhat=0.f,l_reg=0.f;f32x16 o[2];o[0]=f32x16{};o[1]=f32x16{};
  const int qrel=wid*QBLK+r32;
  #define CMASK(P0,P1,t) do{int jb_=(t)-band0; if(jb_>=0)cmask(P0,P1,jb_,qrel,hi);}while(0)
  bool resc=false;
  #define START(P0,P1) do{ const float rm=rowmax(P0,P1); resc=false; \
    { const float dl=rm; mhat=fadd_s(mhat,dl); \
      _Pragma("unroll") for(int r=0;r<16;++r){P0[r]=fsub_s(P0[r],dl);P1[r]=fsub_s(P1[r],dl);} \
       } \
    _Pragma("unroll") for(int r=0;r<16;++r)P0[r]=__builtin_amdgcn_exp2f(P0[r]); }while(0)
  #define RESC() do{ if(resc){ asm volatile("s_waitcnt lgkmcnt(0)":::"memory"); \
      _Pragma("unroll") for(int d_=0;d_<2;++d_) _Pragma("unroll") for(int r=0;r<16;++r)o[d_][r]*=wsf[crow(r,hi)]; } }while(0)
  f32x16 pA0,pA1,pB0,pB1;
  int sl_prev=0,sl_cur=0,sl_next=SLOTB;
  #define ROT() do{sl_prev=sl_cur;sl_cur=sl_next;sl_next=(sl_next==(NSLOT-1)*SLOTB)?0:sl_next+SLOTB;}while(0)
  DMA_K(2,2*SLOTB);
  WAIT_BAR(3);
  { const f32x16 zc_=f32x16{}; qkt(pA0,pA1,Kbase,qr,zc_,r32,hi); }asm volatile("s_nop 15\n\ts_nop 7":"+v"(pA0),"+v"(pA1));ADDK(pA0,pA1,0);CMASK(pA0,pA1,0);
  START(pA0,pA1);
  _Pragma("unroll") for(int r=0;r<16;++r)pA1[r]=__builtin_amdgcn_exp2f(pA1[r]);
  WAIT_BAR(0);
  DMA_K(3,0);DMA_V(1,SLOTB);
  ROT();
  kload8(kf,kp0+sl_cur);
  WAIT_BAR(2);
  s16x4 vlo[8],vhi[8]; u32x4 pw0,pw1,pw2,pw3;
  #define PKW(P,B) cvtpk_s(P[B],P[B+1])
  #define PAF(k) __builtin_bit_cast(bf16x8,pw##k)
  #define VFR(i) (bf16x8){vlo[i][0],vlo[i][1],vlo[i][2],vlo[i][3],vhi[i][0],vhi[i][1],vhi[i][2],vhi[i][3]}
  #define PIN(x) asm volatile("":"+v"(x))
  #define MX3(a,b,c) __builtin_fmaxf(__builtin_fmaxf((a),(b)),(c))
  #define GAPA(MF,A0,A1,A2,A3,W0,W1,PW) do{ MF; sacc+=A0; sacc+=A1; sacc+=A2; sacc+=A3; PIN(sacc); W0; W1; PIN(PW); SBAR(); }while(0)
  #define EX(v) __builtin_amdgcn_exp2f(v)
  #define GAPB(MF,X,B) do{ MF; X[B]=EX(X[B]); X[B+1]=EX(X[B+1]); X[B+2]=EX(X[B+2]); X[B+3]=EX(X[B+3]); PIN(X); SBAR(); }while(0)
  #define VRD(i) do{ vlo[i]=vtr(vp_+(((i)>>2)*4096+((i)&3)*1024)); vhi[i]=vtr(vp_+(((i)>>2)*4096+((i)&3)*1024+512)); }while(0)
  #define KRD(G,j) do{ if(G){ kload2(kf,kp0+sl_next,j); SBAR(); } }while(0)
  #define STEP(C0,C1,P0,P1,t,GK,GV,GL) do{ SBAR(); \
    const lds_cptr vp_=vp0+sl_prev; \
    bf16x8 qa_=QP(0),qb_=QP(1); VRD(0); SBAR(); float sacc=(P0[0]+P0[1]); \
    GAPA(C0=__builtin_amdgcn_mfma_f32_32x32x16_bf16(kf[0],qa_,(f32x16){},0,0,0), P0[2],P0[3],P0[4],P0[5],     pw0[0]=PKW(P0,0), pw0[1]=PKW(P0,2), pw0); \
    VRD(4); SBAR(); GAPA(C1=__builtin_amdgcn_mfma_f32_32x32x16_bf16(kf[1],qa_,(f32x16){},0,0,0), P0[6],P0[7],P0[8],P0[9],     pw0[2]=PKW(P0,4), pw0[3]=PKW(P0,6), pw0); \
    qa_=QP(2); VRD(1); SBAR(); GAPA(C0=__builtin_amdgcn_mfma_f32_32x32x16_bf16(kf[2],qb_,C0,0,0,0),   P0[10],P0[11],P0[12],P0[13], pw1[0]=PKW(P0,8), pw1[1]=PKW(P0,10), pw1); \
    VRD(5); SBAR(); GAPA(C1=__builtin_amdgcn_mfma_f32_32x32x16_bf16(kf[3],qb_,C1,0,0,0),   P0[14],P0[15],P1[0],P1[1],   pw1[2]=PKW(P0,12),pw1[3]=PKW(P0,14), pw1); \
    qb_=QP(3); VRD(2); SBAR(); GAPA(C0=__builtin_amdgcn_mfma_f32_32x32x16_bf16(kf[4],qa_,C0,0,0,0),   P1[2],P1[3],P1[4],P1[5],     pw2[0]=PKW(P1,0), pw2[1]=PKW(P1,2), pw2); \
    VRD(6); SBAR(); GAPA(C1=__builtin_amdgcn_mfma_f32_32x32x16_bf16(kf[5],qa_,C1,0,0,0),   P1[6],P1[7],P1[8],P1[9],     pw2[2]=PKW(P1,4), pw2[3]=PKW(P1,6), pw2); \
    VRD(3); SBAR(); GAPA(C0=__builtin_amdgcn_mfma_f32_32x32x16_bf16(kf[6],qb_,C0,0,0,0),   P1[10],P1[11],P1[12],P1[13], pw3[0]=PKW(P1,8), pw3[1]=PKW(P1,10), pw3); \
    VRD(7); SBAR(); GAPA(C1=__builtin_amdgcn_mfma_f32_32x32x16_bf16(kf[7],qb_,C1,0,0,0),   P1[14],P1[15],0.f,0.f,       pw3[2]=PKW(P1,12),pw3[3]=PKW(P1,14), pw3); \
    l_reg+=sacc; \
    if(GK){DMA_K((t)+3,sl_cur);} if(GV){DMA_V((t)+1,sl_next);} \
    ADDK(C0,C1,t); CMASK(C0,C1,t); \
    { float a=MX3(C0[0],C0[1],C1[0]),b=MX3(C0[2],C0[3],C1[1]); a=MX3(a,C1[2],C1[3]); \
      _Pragma("unroll") for(int r=4;r<16;r+=4){a=MX3(a,C0[r],C0[r+1]);b=MX3(b,C0[r+2],C0[r+3]);a=MX3(a,C1[r],C1[r+1]);b=MX3(b,C1[r+2],C1[r+3]);} \
      float rm=__builtin_fmaxf(a,b); { auto rr=__builtin_amdgcn_permlane32_swap(__float_as_uint(rm),__float_as_uint(rm),false,false); rm=__builtin_fmaxf(__uint_as_float(rr[0]),__uint_as_float(rr[1])); } \
      resc=false; \
      if(__builtin_expect(__any(rm>(float)THRL),0)){ const float dl=__builtin_fmaxf(rm,0.f); mhat+=dl; \
        _Pragma("unroll") for(int r=0;r<16;++r){C0[r]-=dl;C1[r]-=dl;} \
         \
        const float f=__builtin_amdgcn_exp2f(-dl); l_reg*=f; if(hi==0)wsf[r32]=f; resc=true; } } \
    SBAR(); \
    GAPB(o[0]=__builtin_amdgcn_mfma_f32_32x32x16_bf16(PAF(0),VFR(0),o[0],0,0,0), C0,0); \
    GAPB(o[1]=__builtin_amdgcn_mfma_f32_32x32x16_bf16(PAF(0),VFR(4),o[1],0,0,0), C0,4); \
    KRD(GL,0); GAPB(o[0]=__builtin_amdgcn_mfma_f32_32x32x16_bf16(PAF(1),VFR(1),o[0],0,0,0), C0,8); \
    KRD(GL,1); GAPB(o[1]=__builtin_amdgcn_mfma_f32_32x32x16_bf16(PAF(1),VFR(5),o[1],0,0,0), C0,12); \
    KRD(GL,2); GAPB(o[0]=__builtin_amdgcn_mfma_f32_32x32x16_bf16(PAF(2),VFR(2),o[0],0,0,0), C1,0); \
    KRD(GL,3); GAPB(o[1]=__builtin_amdgcn_mfma_f32_32x32x16_bf16(PAF(2),VFR(6),o[1],0,0,0), C1,4); \
    GAPB(o[0]=__builtin_amdgcn_mfma_f32_32x32x16_bf16(PAF(3),VFR(3),o[0],0,0,0), C1,8); \
    GAPB(o[1]=__builtin_amdgcn_mfma_f32_32x32x16_bf16(PAF(3),VFR(7),o[1],0,0,0), C1,12); \
    }while(0)
  int t=1;
  #undef CMASK
  #define CMASK(P0,P1,t) do{}while(0)
  for(;t+5<NT;t+=2){
    STEP(pB0,pB1,pA0,pA1,t,true,true,true);     WAIT_BAR(2); RESC(); ROT();
    STEP(pA0,pA1,pB0,pB1,t+1,true,true,true);   WAIT_BAR(2); RESC(); ROT();
  }
  #undef CMASK
  #define CMASK(P0,P1,t) do{int jb_=(t)-band0; if(jb_>=0)cmask(P0,P1,jb_,qrel,hi);}while(0)
  #define ENDW(tt) do{ if((tt)+3<NT){WAIT_BAR(2);} else if((tt)+2<NT){WAIT_BAR(1);} else {WAIT_BAR(0);} }while(0)
  for(;t+1<NT;t+=2){
    STEP(pB0,pB1,pA0,pA1,t,(t+3<NT),(t+1<NT),(t+1<NT));       ENDW(t);   RESC(); ROT();
    STEP(pA0,pA1,pB0,pB1,t+1,(t+4<NT),(t+2<NT),(t+2<NT));     ENDW(t+1); RESC(); ROT();
  }
  STEP(pB0,pB1,pA0,pA1,NT-1,false,false,false); RESC();
  { float sacc=pB0[0]+pB0[1]; _Pragma("unroll") for(int r=2;r<16;++r)sacc+=pB0[r]; _Pragma("unroll") for(int r=0;r<16;++r)sacc+=pB1[r]; l_reg+=sacc;
    pw0=(u32x4){PKW(pB0,0),PKW(pB0,2),PKW(pB0,4),PKW(pB0,6)};pw1=(u32x4){PKW(pB0,8),PKW(pB0,10),PKW(pB0,12),PKW(pB0,14)};pw2=(u32x4){PKW(pB1,0),PKW(pB1,2),PKW(pB1,4),PKW(pB1,6)};pw3=(u32x4){PKW(pB1,8),PKW(pB1,10),PKW(pB1,12),PKW(pB1,14)};
    SBAR(); pv(o,vb0+sl_cur,PAF(0),PAF(1),PAF(2),PAF(3)); }
  #undef PKW
  #undef PAF
  #undef VFR
  #undef PIN
  #undef MX3
  #undef GAPA
  #undef GAPB
  #undef EX
  #undef VRD
  #undef KRD
  #undef STEP
  #undef ENDW
  {auto rr=__builtin_amdgcn_permlane32_swap(__float_as_uint(l_reg),__float_as_uint(l_reg),false,false);l_reg=__uint_as_float(rr[0])+__uint_as_float(rr[1]);}
  if(hi==0)wsf[32+r32]=l_reg;asm volatile("s_waitcnt lgkmcnt(0)":::"memory");
  float rli[16];
  #pragma unroll
  for(int r=0;r<16;++r)rli[r]=__builtin_amdgcn_rcpf(wsf[32+crow(r,hi)]);
  bf16*Ow=O+(rowbase+q0+wid*QBLK)*PO+h*D;
  { bf16*stg=(bf16*)(shm+LDS_OST)+wid*2048;
    #pragma unroll
    for(int r=0;r<16;++r){const int orow=crow(r,hi);
      #pragma unroll
      for(int d0=0;d0<2;++d0)stg[orow*64+d0*32+r32]=__float2bfloat16(o[d0][r]*rli[r]);}
    asm volatile("s_waitcnt lgkmcnt(0)":::"memory");
    #pragma unroll
    for(int i=0;i<4;++i){const int row=i*8+(lane>>3),ch=lane&7; const u32x4 v=*(const u32x4*)(stg+row*64+ch*8); if(q0+wid*QBLK+row<TTOK)ATTN_STORE16(Ow+(long)row*PO+ch*8,v);} }
  asm volatile("s_waitcnt lgkmcnt(0)\n\ts_barrier":::"memory");
  #undef ADDK
  #undef QP
  #undef DMA_K
  #undef DMA_V
  #undef CMASK
  #undef START
  #undef RESC
  #undef ROT
}
constexpr int QA_OFF=0,KA_OFF=512,VA_OFF=640;
__device__ __forceinline__ void swa_unit(int lb,int kvh,int a,const bf16*__restrict__ P,bf16*OC,const float*__restrict__ rel,const float*__restrict__ sinks,char*shm,int wv){
  const int tid=otid(wv),lane=tid&63,r32=lane&31,hi=lane>>5; const int wid=__builtin_amdgcn_readfirstlane(tid>>6);
  const int g=wid>>1,half=wid&1,hq=kvh*4+g;
  const long rowbase=(long)lb*TTOK;
  const unsigned lds0=(unsigned)(uintptr_t)shm; const lds_cptr shm3=(lds_cptr)shm;
  float*wsf=(float*)(shm+LDS_WS)+wid*64;
  const float LOG2E=1.4426950408889634f;
  { const int gg=tid>>7,d=tid&127; int bk=d; if(d>=16){ bk=16+(int)(logf((float)d*(1.f/16.f))*(16.f/2.0794415416798357f)); if(bk>31)bk=31; }
    ((__attribute__((address_space(3))) float*)(shm3+LDS_DK))[tid]=rel[bk*8+kvh*4+gg]*LOG2E; }
  const int t_lo=a>=2?a-2:0; const int ntile=a-t_lo+1;
  const bf16*Kh=P+rowbase*PQ+KA_OFF+kvh*64,*Vh=P+rowbase*PQ+VA_OFF+kvh*64;
  const bf16*ksrc=Kh+(long)lane*PQ+wid*8;
  const bf16*vsrc=Vh+(long)(16*(wid&3)+(lane>>2))*PQ+(wid>>2)*32+(lane&3)*8;
  #pragma unroll
  for(int j=0;j<3;++j) if(j<ntile){
    glds16(ksrc+(long)(t_lo+j)*KVBLK*PQ,(unsigned)__builtin_amdgcn_readfirstlane(lds0+LDS_K+wid*1024+j*SLOTB));
    glds16(vsrc+(long)(t_lo+j)*KVBLK*PQ,(unsigned)__builtin_amdgcn_readfirstlane(lds0+LDS_V+wid*1024+j*SLOTB)); }
  const int qpos=64*a+32*half+r32;
  const bf16*Qw=P+(rowbase+64*a+32*half)*PQ+QA_OFF+hq*64;
  bf16x8 qr[4];
  #pragma unroll
  for(int d0=0;d0<4;++d0)qr[d0]=*reinterpret_cast<const bf16x8*>(&Qw[(long)r32*PQ+d0*16+hi*8]);
  const float sink2=sinks[hq]*LOG2E;
  asm volatile("s_waitcnt vmcnt(0) lgkmcnt(0)\n\ts_barrier":::"memory");
  f32x16 S0[3],S1[3]; f32x16 zero=f32x16{};
  #pragma unroll
  for(int j=0;j<3;++j){ S0[j]=f32x16{}; S1[j]=f32x16{}; if(j<ntile){ qkt(S0[j],S1[j],shm+LDS_K+j*SLOTB,qr,zero,r32,hi); } }
  const __attribute__((address_space(3))) float* bt=(const __attribute__((address_space(3))) float*)(shm3+LDS_DK)+g*128;
  float mx=sink2;
  #pragma unroll
  for(int j=0;j<3;++j){
    #pragma unroll
    for(int r=0;r<16;++r){
      const int kv=64*(t_lo+j)+crow(r,hi); const int d0_=qpos-kv, d1_=d0_-32;
      const bool ok0=(j<ntile)&&(d0_>=0)&&(d0_<128), ok1=(j<ntile)&&(d1_>=0)&&(d1_<128);
      const float s0=ok0?S0[j][r]+bt[d0_&127]:-INFINITY, s1=ok1?S1[j][r]+bt[d1_&127]:-INFINITY;
      S0[j][r]=s0; S1[j][r]=s1; mx=fmaxf(mx,fmaxf(s0,s1)); } }
  mx=fmaxf(mx,bperm_f(lane^32,mx));
  float l=0.f;
  #pragma unroll
  for(int j=0;j<3;++j){
    #pragma unroll
    for(int r=0;r<16;++r){ const float p0=__builtin_amdgcn_exp2f(S0[j][r]-mx), p1=__builtin_amdgcn_exp2f(S1[j][r]-mx); S0[j][r]=p0; S1[j][r]=p1; l+=p0+p1; } }
  l+=bperm_f(lane^32,l); l+=__builtin_amdgcn_exp2f(sink2-mx);
  f32x16 o[2]; o[0]=f32x16{}; o[1]=f32x16{};
  const int vb0=(int)(lds0+LDS_V)+((lane>>4)&1)*32+(lane&3)*8+(4*hi+((lane&15)>>2))*64;
  #define PKW(P,B) cvtpk_s(P[B],P[B+1])
  #pragma unroll
  for(int j=0;j<3;++j) if(j<ntile){
    u32x4 pw0=(u32x4){PKW(S0[j],0),PKW(S0[j],2),PKW(S0[j],4),PKW(S0[j],6)},pw1=(u32x4){PKW(S0[j],8),PKW(S0[j],10),PKW(S0[j],12),PKW(S0[j],14)};
    u32x4 pw2=(u32x4){PKW(S1[j],0),PKW(S1[j],2),PKW(S1[j],4),PKW(S1[j],6)},pw3=(u32x4){PKW(S1[j],8),PKW(S1[j],10),PKW(S1[j],12),PKW(S1[j],14)};
    pv(o,vb0+j*SLOTB,__builtin_bit_cast(bf16x8,pw0),__builtin_bit_cast(bf16x8,pw1),__builtin_bit_cast(bf16x8,pw2),__builtin_bit_cast(bf16x8,pw3)); }
  #undef PKW
  if(hi==0)wsf[32+r32]=l; asm volatile("s_waitcnt lgkmcnt(0)":::"memory");
  float rli[16];
  #pragma unroll
  for(int r=0;r<16;++r)rli[r]=__builtin_amdgcn_rcpf(wsf[32+crow(r,hi)]);
  bf16*Ow=OC+(rowbase+64*a+32*half)*PO+hq*64;
  { bf16*stg=(bf16*)(shm+LDS_OST)+wid*2048;
    #pragma unroll
    for(int r=0;r<16;++r){const int orow=crow(r,hi);
      #pragma unroll
      for(int d0=0;d0<2;++d0)stg[orow*64+d0*32+r32]=__float2bfloat16(o[d0][r]*rli[r]);}
    asm volatile("s_waitcnt lgkmcnt(0)":::"memory");
    #pragma unroll
    for(int i=0;i<4;++i){const int row=i*8+(lane>>3),ch=lane&7; const u32x4 v=*(const u32x4*)(stg+row*64+ch*8); if(64*a+32*half+row<TTOK)*(u32x4*)(Ow+(long)row*PO+ch*8)=v;} }
  asm volatile("s_waitcnt lgkmcnt(0)\n\ts_barrier":::"memory");
}
#undef SBAR
#undef WAIT_BAR
}

#define GAS __attribute__((address_space(1)))
#define LAS __attribute__((address_space(3)))
typedef unsigned short bf16;
typedef unsigned v4u __attribute__((ext_vector_type(4)));
typedef float f32x4 __attribute__((ext_vector_type(4)));
typedef short bf16x8 __attribute__((ext_vector_type(8)));
typedef GAS unsigned gu32;
typedef GAS unsigned long long gu64;
#define RLX_AGENT __ATOMIC_RELAXED, __HIP_MEMORY_SCOPE_AGENT
#define LDS_WAIT() asm volatile("s_waitcnt lgkmcnt(0)" ::: "memory")
#define VM_WAIT() asm volatile("s_waitcnt vmcnt(0)" ::: "memory")
__device__ __forceinline__ unsigned long long rt() { return __builtin_amdgcn_s_memrealtime(); }
__device__ __forceinline__ unsigned f2bf(float f) { unsigned u = __builtin_bit_cast(unsigned, f); return (u + 0x7fffu + ((u >> 16) & 1u)) >> 16; }
__device__ __forceinline__ unsigned pk2(float lo, float hi) { return f2bf(lo) | (f2bf(hi) << 16); }

#define XB_TMO      128
#define XB_XCNT(j)  (256  + 64 * (j))
#define XB_XSUB(j)  (1280 + 64 * (j))
#define XB_XGEN(j)  (2304 + 64 * (j))
#define XB_TOP      3328
#define XB_TOPGEN   3392
#define XCD_BAR_WORDS 3456
#define XB_SPIN_CAP (1u << 18)

__device__ __forceinline__ unsigned xb_ld(unsigned* p)              { return __hip_atomic_load(p, __ATOMIC_RELAXED, __HIP_MEMORY_SCOPE_AGENT); }
__device__ __forceinline__ unsigned xb_add(unsigned* p, unsigned v) { return __hip_atomic_fetch_add(p, v, __ATOMIC_RELAXED, __HIP_MEMORY_SCOPE_AGENT); }
__device__ __forceinline__ unsigned xb_xcc_id() { return (unsigned)__builtin_amdgcn_s_getreg((3 << 11) | 20) & 0xFu; }
#define XB_SPIN(cond, bar) do { unsigned _sp = 0; while (cond) { __builtin_amdgcn_s_sleep(1); \
    if ((++_sp & 255u) == 0u) { if (xb_ld(&(bar)[XB_TMO])) break; if (_sp > XB_SPIN_CAP) { atomicAdd(&(bar)[XB_TMO], 1u); break; } } } } while (0)

struct XcdBarrier {
    unsigned* bar; unsigned x;
    volatile LAS unsigned* st;
};

__device__ __forceinline__ XcdBarrier xcd_barrier_post(unsigned* bar, volatile LAS unsigned* st) {
    XcdBarrier b; b.bar = bar; b.x = xb_xcc_id(); b.st = st;
    if (threadIdx.x == 0) (void)xb_add(&bar[XB_XCNT(b.x)], 1u);
    return b;
}
__device__ __forceinline__ void xcd_barrier_complete(unsigned* bar, unsigned x, unsigned& nloc, unsigned& nx) {
    const unsigned G = gridDim.x * gridDim.y * gridDim.z;
    unsigned sum, cnt, mine, sp = 0u;
    for (;;) {
        sum = 0u; cnt = 0u; mine = 0u;
#pragma unroll
        for (unsigned j = 0; j < 16; ++j) { const unsigned c = xb_ld(&bar[XB_XCNT(j)]); sum += c; cnt += (c > 0u) ? 1u : 0u; mine = (j == x) ? c : mine; }
        if (sum == G) break;
        __builtin_amdgcn_s_sleep(1);
        if ((++sp & 255u) == 0u) { if (xb_ld(&bar[XB_TMO])) break; if (sp > XB_SPIN_CAP) { atomicAdd(&bar[XB_TMO], 1u); break; } }
    }
    nloc = mine > 0u ? mine : 1u; nx = cnt > 0u ? cnt : 1u;
}

__device__ __forceinline__ void xcd_barrier(const XcdBarrier& b) {
    asm volatile("s_waitcnt vmcnt(0)" ::: "memory");
    __syncthreads();
    if (threadIdx.x == 0) {
        unsigned* bar = b.bar;
        __builtin_amdgcn_s_waitcnt(0);
        unsigned nloc = b.st[0], nx = b.st[1];
        if (nloc == 0u) { xcd_barrier_complete(bar, b.x, nloc, nx); b.st[0] = nloc; b.st[1] = nx; }
        const unsigned old = xb_add(&bar[XB_XSUB(b.x)], 1u);
        const unsigned gen = old / nloc;
        if (old + 1u == (gen + 1u) * nloc) {
            __builtin_amdgcn_fence(__ATOMIC_RELEASE, "agent");
            asm volatile("s_waitcnt vmcnt(0)" ::: "memory");
            const unsigned og = xb_add(&bar[XB_TOP], 1u);
            const unsigned tg = og / nx;
            if (og + 1u == (tg + 1u) * nx) xb_add(&bar[XB_TOPGEN], 1u);
            else XB_SPIN(xb_ld(&bar[XB_TOPGEN]) == tg, bar);
            __builtin_amdgcn_fence(__ATOMIC_ACQUIRE, "agent");
            xb_add(&bar[XB_XGEN(b.x)], 1u);
            asm volatile("s_waitcnt vmcnt(0)" ::: "memory");
        } else {
            XB_SPIN(xb_ld(&bar[XB_XGEN(b.x)]) == gen, bar);
            __builtin_amdgcn_fence(__ATOMIC_ACQUIRE, "agent");
            asm volatile("s_waitcnt vmcnt(0)" ::: "memory");
        }
    }
    __syncthreads();
}

constexpr int NWAVES = 8;
constexpr int T_TOK = 4112, M_TOK = 32896, DMODEL = 1024, NPROJ = 6656, DFF = 2816, MP = 33280;
constexpr int HALF_ROWS = 4 * T_TOK  , NT_HALF = 65, MLOC = 16896  ;
constexpr int QA_OFF = 0, KA_OFF = 512, VA_OFF = 640, QF_OFF = 768, KF_OFF = 1280, VF_OFF = 1792, XC_OFF = 2304, YC_OFF = 2816, GATE_OFF = 3328, FL_OFF = 6400;
constexpr int LRU_CH = 129;
constexpr float C2 = 0.125f * 1.4426950408889634f, LOG2E = 1.4426950408889634f;
constexpr size_t MiB = 1u << 20;
constexpr size_t WS_CTL = 0, CTL_ZERO_BYTES = 64 * 1024;
constexpr size_t WS_SSQA = 1 * MiB, WS_SSQB = WS_SSQA + 512 * 1024, WS_HMETA = 2 * MiB  , WS_FL = 3 * MiB  , WS_DK = 4 * MiB  ;
constexpr size_t WS_LRUP = 5 * MiB  , WS_LRUH = 7 * MiB;
constexpr size_t WS_WIN = 9 * MiB;
constexpr size_t WS_WB = WS_WIN + 13 * MiB;
constexpr size_t WS_WOUT = WS_WB + 3 * MiB;
constexpr size_t WS_WFFI = WS_WOUT + 2 * MiB;
constexpr size_t WS_WFFO = WS_WFFI + 11 * MiB;
constexpr size_t WS_WR = WS_WFFO + 6 * MiB, WS_WI = WS_WR + 65536;
constexpr size_t WS_PART = 44 * MiB + 256 * 1024;
constexpr size_t WS_HB = 46 * MiB;
constexpr size_t WS_MG = WS_HB + 65 * MiB;
constexpr size_t WS_OC = WS_MG + 65 * MiB;
constexpr size_t WS_PROJ = WS_OC + 50 * MiB;
constexpr size_t WS_W2ND = WS_PROJ + 215 * MiB;
constexpr size_t WS_WSET = WS_W2ND - WS_WIN;
constexpr size_t WS_PARTK = WS_W2ND + 37 * MiB;
constexpr size_t WS_END = WS_PARTK + 6 * MiB;
static_assert(WS_WI + 65536 <= WS_HB && (size_t)MP * 1024 * 2 <= 65 * MiB && (size_t)MLOC * 1536 * 2 <= 50 * MiB && (size_t)MLOC * NPROJ * 2 <= 215 * MiB && (size_t)MP * DFF * 2 <= 215 * MiB && WS_END <= 512 * MiB, "ws map");
constexpr int CW_TICK = 8192;
constexpr int CW_BAR = 4096;
constexpr int RING_BYTES = 131072, MISC_OFF = RING_BYTES + 320, LDS_BYTES = 147456;

using pg8::sigmoid_f;
struct Args { const float* in[20]; float* out; unsigned char* ws; int ph_lo, ph_hi; };
struct Frame {
    LAS unsigned char* lds; int tid, lane, wave, G, bid;
    float* out; unsigned char* ws;
};
__device__ __forceinline__ float wave_sum(float v, int lane) {
#pragma unroll
    for (int o = 1; o < 64; o <<= 1) v += bperm_f(lane ^ o, v);
    return v;
}
__device__ __forceinline__ float* hrow(const Frame& F, int m) { const int b = m / T_TOK, t = m - b * T_TOK; return (t < 16) ? (float*)(F.ws + WS_HMETA) + (size_t)(b * 16 + t) * DMODEL : F.out + ((size_t)b * 4096 + (t - 16)) * DMODEL; }

__device__ __forceinline__ void wt_item(const float* __restrict__ W, int ldn, int s0, int nv, int K, bf16* WT, int n0, const float* __restrict__ kscale, float cs, LAS float* scr, int kb, int lane) {
    const int k0 = 64 * kb;
    { const int c4 = (lane & 7) * 4, r0 = lane >> 3;
        f32x4 v[8]; float ks[8];
#pragma unroll
        for (int i = 0; i < 8; ++i) { const int kk = r0 + 8 * i; ks[i] = kscale ? kscale[k0 + kk] : 1.f;
            v[i] = *(const f32x4*)(W + (size_t)(k0 + kk) * ldn + s0 + (c4 < nv ? c4 : 0)); }
#pragma unroll
        for (int i = 0; i < 8; ++i) { const int kk = r0 + 8 * i; const float m_ = (c4 < nv) ? ks[i] * cs : 0.f;
            scr[kk * 33 + c4 + 0] = v[i][0] * m_; scr[kk * 33 + c4 + 1] = v[i][1] * m_; scr[kk * 33 + c4 + 2] = v[i][2] * m_; scr[kk * 33 + c4 + 3] = v[i][3] * m_; } }
    LDS_WAIT(); asm volatile("" ::: "memory");
    const int c = lane & 7;
#pragma unroll
    for (int j = 0; j < 4; ++j) { const int n = (lane >> 3) + 8 * j; const LAS float* s = scr + (8 * c) * 33 + n;
        v4u o; o.x = pk2(s[0 * 33], s[1 * 33]); o.y = pk2(s[2 * 33], s[3 * 33]); o.z = pk2(s[4 * 33], s[5 * 33]); o.w = pk2(s[6 * 33], s[7 * 33]);
        *(GAS v4u*)(WT + (size_t)(n0 + n) * K + k0 + 8 * c) = o; }
    LDS_WAIT(); asm volatile("" ::: "memory");
}
__device__ __forceinline__ void wconv_phase(Frame& F, int l, int skip, const float* norm_mix, const float* w_in, const float* lru_wr, const float* lru_wi, const float* w_branch, const float* w_out, const float* norm_ffn, const float* w_ffi, const float* w_ffo) {
    LAS float* scr = (LAS float*)(F.lds + F.wave * 16384);
    if (F.bid < skip) return;
    const int gw = (F.bid - skip) * NWAVES + F.wave, NGW = (F.G - skip) * NWAVES; const size_t wo = (l & 1) ? WS_WSET : 0;
    constexpr int I_IN = 16 * 208, I_FFI = 16 * 176, I_WB = 3 * 8 * 32, I_OUT = 16 * 32, I_FFO = 44 * 32, I_LRU = 2 * 8 * 2;
    constexpr int NITEMS = I_IN + I_FFI + I_WB + I_OUT + I_FFO + I_LRU;
    bf16* Win_t = (bf16*)(F.ws + wo + WS_WIN); bf16* Wb_t = (bf16*)(F.ws + wo + WS_WB); bf16* Wout_t = (bf16*)(F.ws + wo + WS_WOUT); bf16* Wffi_t = (bf16*)(F.ws + wo + WS_WFFI); bf16* Wffo_t = (bf16*)(F.ws + wo + WS_WFFO);
    for (int it = gw; it < NITEMS; it += NGW) {
        int r = it;
        if (r < I_IN) { const int kb = r / 208, nb = r % 208, n0 = 32 * nb; int s0, nv = 32; float cs = 1.f;
            if (n0 < 2304) { s0 = n0; if (n0 < 512 || (n0 >= 768 && n0 < 1280)) cs = C2; } else if (n0 < 6400) s0 = n0 + 8; else if (n0 == 6400) { s0 = 2304; nv = 8; } else { s0 = 0; nv = 0; }
            wt_item(w_in + (size_t)l * 1024 * 6408, 6408, s0, nv, 1024, Win_t, n0, norm_mix + l * 1024, cs, scr, kb, F.lane); continue; } r -= I_IN;
        if (r < I_FFI) { const int kb = r / 176, nb = r % 176, n0 = 32 * nb, pn = n0 >> 8, w = n0 & 255; const int s0 = (w < 128) ? 128 * pn + w : 2816 + 128 * pn + (w - 128);
            wt_item(w_ffi + (size_t)l * 1024 * 5632, 5632, s0, 32, 1024, Wffi_t, n0, norm_ffn + l * 1024, 1.f, scr, kb, F.lane); continue; } r -= I_FFI;
        if (r < I_WB) { const int g = r / 256, q = r % 256, kb = q / 32, nb = q % 32;
            wt_item(w_branch + (size_t)(l * 3 + g) * 512 * 1024, 1024, 32 * nb, 32, 512, Wb_t, g * 1024 + 32 * nb, nullptr, 1.f, scr, kb, F.lane); continue; } r -= I_WB;
        if (r < I_OUT) { const int kb = r / 32, nb = r % 32;
            wt_item(w_out + (size_t)l * 1024 * 1024, 1024, 32 * nb, 32, 1024, Wout_t, 32 * nb, nullptr, 1.f, scr, kb, F.lane); continue; } r -= I_OUT;
        if (r < I_FFO) { const int kb = r / 32, nb = r % 32;
            wt_item(w_ffo + (size_t)l * 2816 * 1024, 1024, 32 * nb, 32, 2816, Wffo_t, 32 * nb, nullptr, 1.f, scr, kb, F.lane); continue; } r -= I_FFO;
        { const int mat = r / 16, q = r % 16, h = q / 2, nb = q % 2;
            wt_item((mat ? lru_wi : lru_wr) + (size_t)(l * 8 + h) * 4096, 64, 32 * nb, 32, 64, (bf16*)(F.ws + wo + (mat ? WS_WI : WS_WR)) + h * 4096, 32 * nb, nullptr, 1.f, scr, 0, F.lane); }
    }
}
__device__ __forceinline__ void init_phase(Frame& F, const float* x, const float* meta) {
    const int gw = F.bid * NWAVES + F.wave, NGW = F.G * NWAVES;
    bf16* hb = (bf16*)(F.ws + WS_HB); unsigned long long* ssqA = (unsigned long long*)(F.ws + WS_SSQA); unsigned long long* ssqB = (unsigned long long*)(F.ws + WS_SSQB);
    for (int m = gw; m < MP; m += NGW) {
        GAS unsigned long long* o8 = (GAS unsigned long long*)(hb + (size_t)m * DMODEL) + F.lane;
        if (m < M_TOK) { const int b = m / T_TOK, t = m - b * T_TOK;
            const float* src = (t < 16) ? meta + (size_t)t * DMODEL : x + ((size_t)b * 4096 + (t - 16)) * DMODEL;
            const GAS f32x4* xr = (const GAS f32x4*)src + F.lane; GAS f32x4* hr = (GAS f32x4*)hrow(F, m) + F.lane;
            float s = 0.f;
#pragma unroll
            for (int j = 0; j < 4; ++j) { const f32x4 v = xr[64 * j]; hr[64 * j] = v; s += (v.x * v.x + v.y * v.y) + (v.z * v.z + v.w * v.w);
                o8[64 * j] = (unsigned long long)pk2(v.x, v.y) | ((unsigned long long)pk2(v.z, v.w) << 32); }
            s = wave_sum(s, F.lane); if (F.lane == 0) { unsigned long long z = 0ull; asm volatile("" : "+v"(z)); ssqB[m] = (unsigned long long)(s * 1048576.0f); ssqA[m] = z; }
        } else {
            unsigned long long z = 0ull; asm volatile("" : "+v"(z));
#pragma unroll
            for (int j = 0; j < 4; ++j) o8[64 * j] = z;
            if (F.lane == 0) { ssqB[m] = z; ssqA[m] = z; }
        }
    }
}
__device__ __forceinline__ void final_phase(Frame& F, const float* norm_final) {
    const int gw = F.bid * NWAVES + F.wave, NGW = F.G * NWAVES; const unsigned long long* ssqB = (const unsigned long long*)(F.ws + WS_SSQB);
    for (int r = gw; r < 32768; r += NGW) { const int b = r >> 12, tt = r & 4095, m = b * T_TOK + 16 + tt;
        const float s = rsqrtf((float)ssqB[m] * (1.0f / (1024.0f * 1048576.0f)) + 1e-6f);
        GAS f32x4* hr = (GAS f32x4*)(F.out + (size_t)r * DMODEL) + F.lane; const GAS f32x4* gr = (const GAS f32x4*)norm_final + F.lane;
#pragma unroll
        for (int j = 0; j < 4; ++j) { f32x4 v = hr[64 * j]; const f32x4 g = gr[64 * j]; v = v * s * g; hr[64 * j] = v; } }
}
__device__ __forceinline__ void zero_u64(Frame& F, unsigned long long* p, int n) { unsigned long long z = 0ull; asm volatile("" : "+v"(z)); for (int i = F.bid * NWAVES * 64 + F.tid; i < n; i += F.G * NWAVES * 64) p[i] = z; }

__device__ __forceinline__ void fixup_phase(Frame& F) {
    if (F.bid >= 2) return;
    const int half = F.bid; const bf16* part = (const bf16*)(F.ws + WS_PART) + (size_t)half * 3 * 64 * 1024; bf16* mg = (bf16*)(F.ws + WS_MG) + (size_t)(half * HALF_ROWS + 16384) * DMODEL;
    for (int i = F.tid; i < 64 * 128; i += NWAVES * 64) { const v4u a = *(const v4u*)(part + (size_t)i * 8), b = *(const v4u*)(part + 65536 + (size_t)i * 8), c = *(const v4u*)(part + 131072 + (size_t)i * 8);
        v4u o;
#define FX_(f) o.f = pk2(__uint_as_float(a.f << 16) + __uint_as_float(b.f << 16) + __uint_as_float(c.f << 16), __uint_as_float(a.f & 0xffff0000u) + __uint_as_float(b.f & 0xffff0000u) + __uint_as_float(c.f & 0xffff0000u))
        FX_(x); FX_(y); FX_(z); FX_(w);
#undef FX_
        *(v4u*)(mg + (size_t)i * 8) = o; }
}
__device__ __forceinline__ void fixk_phase(Frame& F, int npieces, unsigned long long* ssq) {
    if (F.bid >= 128) return;
    const int grow = 32768 + F.bid, c = 2 * F.tid; typedef float f32x2v __attribute__((ext_vector_type(2)));
    const float* pk = (const float*)(F.ws + WS_PARTK) + (size_t)F.bid * DMODEL + c; float* hp = hrow(F, grow) + c;
    f32x2v a = *(const f32x2v*)hp;
    for (int p = 0; p < npieces; ++p) a += *(const f32x2v*)(pk + (size_t)p * 128 * DMODEL);
    *(f32x2v*)hp = a; *(unsigned*)((bf16*)(F.ws + WS_HB) + (size_t)grow * DMODEL + c) = pk2(a.x, a.y);
    const float s = wave_sum(a.x * a.x + a.y * a.y, F.lane);
    if (F.lane == 0) atomicAdd(ssq + grow, (unsigned long long)(s * 1048576.0f));
}
__device__ __forceinline__ float logsig_f(float x) { return fminf(x, 0.f) - __logf(1.f + __expf(-fabsf(x))); }
__device__ __forceinline__ float one_minus_exp(float x) { const float s = -x * (1.f + x * (0.5f + x * 0.16666667f)); const float e = 1.f - __expf(x); return (x > -1e-3f) ? s : e; }
__device__ __forceinline__ void cumsum_unit(Frame& F, int l, int lb, const float* fbias) {
    const int h = F.wave, lane = F.lane; const float* fl = (const float*)(F.ws + WS_FL); float* dk = (float*)(F.ws + WS_DK) + (size_t)(lb * 8 + h) * 4352;
    const float fb = fbias[l * 8 + h]; float carry = 0.f;
    for (int cq = 0; cq < 17; ++cq) { const int t0 = 256 * cq + 4 * lane; float v[4];
#pragma unroll
        for (int j = 0; j < 4; ++j) { const int t = t0 + j; const float x = fl[(size_t)(lb * T_TOK + (t < T_TOK ? t : T_TOK - 1)) * 8 + h]; const float lv = logsig_f(x + fb); v[j] = (t < T_TOK) ? lv : 0.f; }
        v[1] += v[0]; v[2] += v[1]; v[3] += v[2];
        float inc = v[3];
#pragma unroll
        for (int o = 1; o < 64; o <<= 1) { const float u = bperm_f(lane - o, inc); if (lane >= o) inc += u; }
        const float ex = carry + inc - v[3];
        f32x4 o4 = { -(ex + v[0]) * LOG2E, -(ex + v[1]) * LOG2E, -(ex + v[2]) * LOG2E, -(ex + v[3]) * LOG2E };
        *(f32x4*)(dk + t0) = o4;
        carry += bperm_f(63, inc);
    }
}
__device__ __forceinline__ float bf2f(unsigned short u) { return __uint_as_float((unsigned)u << 16); }
__device__ __forceinline__ int crow_(int r, int hi) { return (r & 3) + 8 * (r >> 2) + 4 * hi; }
template <int MODE> __device__ __forceinline__ void lru_unit(Frame& F, int l, int lb, int ch, const float* conv_w, const float* conv_b, const float* lru_br, const float* lru_bi, const float* lam) {
    typedef float f32x16 __attribute__((ext_vector_type(16)));
    const int tid = F.tid, wid = F.wave, lane = F.lane, c = tid, r32 = lane & 31, hi = lane >> 5;
    const bf16* proj = (const bf16*)(F.ws + WS_PROJ);
    const int t0 = ch * 32, nt = (T_TOK - t0) < 32 ? (T_TOK - t0) : 32;
    LAS unsigned short* XCb = (LAS unsigned short*)(F.lds);
    LAS float* MU = (LAS float*)(F.lds);
    LAS float* AS = (LAS float*)(F.lds + 65536);
    LAS unsigned short* XR = (LAS unsigned short*)(F.lds + 65536);
    const unsigned lds0 = (unsigned)(uintptr_t)(unsigned char*)F.lds;
    { const bf16* rowp = proj + (size_t)(lb * T_TOK) * NPROJ + XC_OFF + lane * 8;
#pragma unroll
        for (int i = 0; i < 5; ++i) { const int row = wid + 8 * i; if (row < 35) { int tt = t0 - 3 + row; tt = tt < 0 ? 0 : tt;
            attn_body::glds16(rowp + (size_t)tt * NPROJ, (unsigned)__builtin_amdgcn_readfirstlane(lds0 + 65536 + row * 1024)); } }
    }
    bf16x8 wbr[2][4], wbi[2][4];
    { const size_t wo = (l & 1) ? WS_WSET : 0; const bf16* Wr = (const bf16*)(F.ws + wo + WS_WR) + wid * 4096; const bf16* Wi = (const bf16*)(F.ws + wo + WS_WI) + wid * 4096;
#pragma unroll
        for (int jt = 0; jt < 2; ++jt)
#pragma unroll
            for (int ks = 0; ks < 4; ++ks) { wbr[jt][ks] = *(const bf16x8*)(Wr + (jt * 32 + r32) * 64 + 16 * ks + 8 * hi); wbi[jt][ks] = *(const bf16x8*)(Wi + (jt * 32 + r32) * 64 + 16 * ks + 8 * hi); } }
    const float w0 = conv_w[(l * 4 + 0) * 512 + c], w1 = conv_w[(l * 4 + 1) * 512 + c], w2 = conv_w[(l * 4 + 2) * 512 + c], w3 = conv_w[(l * 4 + 3) * 512 + c], cb = conv_b[l * 512 + c];
    asm volatile("s_waitcnt vmcnt(0)" ::: "memory"); __syncthreads();
    float xcv[32];
    { const float m3 = (t0 >= 3) ? 1.f : 0.f;
        float xm3 = bf2f(XR[0 * 512 + c]) * m3, xm2 = bf2f(XR[1 * 512 + c]) * m3, xm1 = bf2f(XR[2 * 512 + c]) * m3;
#pragma unroll
        for (int t = 0; t < 32; ++t) { const float x0 = bf2f(XR[(t + 3) * 512 + c]);
            xcv[t] = w0 * xm3 + w1 * xm2 + w2 * xm1 + w3 * x0 + cb; xm3 = xm2; xm2 = xm1; xm1 = x0;
            XCb[t * 520 + c] = (unsigned short)f2bf(xcv[t]); } }
    __syncthreads();
    bf16x8 af[4];
#pragma unroll
    for (int ks = 0; ks < 4; ++ks) af[ks] = *(const LAS bf16x8*)(XCb + r32 * 520 + 64 * wid + 16 * ks + 8 * hi);
    __syncthreads();
    f32x16 dr[2], di[2];
    {
#pragma unroll
        for (int jt = 0; jt < 2; ++jt) { dr[jt] = f32x16{}; di[jt] = f32x16{};
#pragma unroll
            for (int ks = 0; ks < 4; ++ks) { dr[jt] = __builtin_amdgcn_mfma_f32_32x32x16_bf16(af[ks], wbr[jt][ks], dr[jt], 0, 0, 0); di[jt] = __builtin_amdgcn_mfma_f32_32x32x16_bf16(af[ks], wbi[jt][ks], di[jt], 0, 0, 0); } } }
#pragma unroll
    for (int jt = 0; jt < 2; ++jt) { const int cc = 64 * wid + 32 * jt + r32; const float brv = lru_br[l * 512 + cc], biv = lru_bi[l * 512 + cc], lsl = 8.0f * logsig_f(lam[l * 512 + cc]);
#pragma unroll
        for (int r = 0; r < 16; ++r) { const int t = crow_(r, hi); const float rr = sigmoid_f(dr[jt][r] + brv), gi = sigmoid_f(di[jt][r] + biv), la = rr * lsl;
            AS[t * 512 + cc] = __expf(la); MU[t * 512 + cc] = __builtin_amdgcn_sqrtf(one_minus_exp(2.0f * la)) * gi; } }
    __syncthreads();
    float* lp = (float*)(F.ws + WS_LRUP) + (size_t)(lb * LRU_CH) * 512 + c; float* lh = (float*)(F.ws + WS_LRUH) + (size_t)(lb * LRU_CH) * 512 + c;
    float h = 0.f, pa = 1.f;
    if (MODE == 1) {
        for (int k0 = 0; k0 < ch; k0 += 16) { float pv_[16], hv_[16];
#pragma unroll
            for (int j = 0; j < 16; ++j) { const int k = (k0 + j < ch) ? k0 + j : ch - 1; pv_[j] = lp[(size_t)k * 512]; hv_[j] = lh[(size_t)k * 512]; }
#pragma unroll
            for (int j = 0; j < 16; j += 4) asm volatile("" :: "v"(pv_[j]), "v"(pv_[j + 1]), "v"(pv_[j + 2]), "v"(pv_[j + 3]), "v"(hv_[j]), "v"(hv_[j + 1]), "v"(hv_[j + 2]), "v"(hv_[j + 3]));
#pragma unroll
            for (int j = 0; j < 16; ++j) { const bool ok = k0 + j < ch; const float hn = pv_[j] * h + hv_[j]; h = ok ? hn : h; } }
    }
#pragma unroll
    for (int t = 0; t < 32; ++t) { const float a = AS[t * 512 + c]; const float hn = a * h + MU[t * 512 + c] * xcv[t]; const bool ok = t < nt; h = ok ? hn : h; pa = ok ? pa * a : pa; if (MODE == 1) MU[t * 512 + c] = hn; }
    if (MODE == 0) { lp[(size_t)ch * 512] = pa; lh[(size_t)ch * 512] = h; }
    __syncthreads();
    if (MODE == 1) {
        { const bf16* rowp = proj + (size_t)(lb * T_TOK + t0) * NPROJ + YC_OFF + lane * 8;
#pragma unroll
            for (int i = 0; i < 4; ++i) { const int row = wid + 8 * i; attn_body::glds16(rowp + (size_t)row * NPROJ, (unsigned)__builtin_amdgcn_readfirstlane(lds0 + 65536 + row * 1024)); } }
        asm volatile("s_waitcnt vmcnt(0)" ::: "memory"); __syncthreads();
        bf16* op = (bf16*)(F.ws + WS_OC) + (size_t)(lb * T_TOK + t0 + wid) * 1536 + 1024 + lane * 8;
        unsigned yo = 65536 + wid * 1024 + lane * 16, ho = wid * 2048 + lane * 32; int row = wid;
#pragma unroll 1
        for (int pss = 0; pss < 4; ++pss, op += 8 * 1536, yo += 8192, ho += 16384, row += 8) {
            const v4u yw = *(const LAS v4u*)(F.lds + yo);
            const f32x4 h0 = *(const LAS f32x4*)(F.lds + ho), h1 = *(const LAS f32x4*)(F.lds + ho + 16);
            float y[8] = { __uint_as_float(yw.x << 16), __uint_as_float(yw.x & 0xffff0000u), __uint_as_float(yw.y << 16), __uint_as_float(yw.y & 0xffff0000u),
                           __uint_as_float(yw.z << 16), __uint_as_float(yw.z & 0xffff0000u), __uint_as_float(yw.w << 16), __uint_as_float(yw.w & 0xffff0000u) };
            float o[8];
#pragma unroll
            for (int j = 0; j < 8; ++j) { const float u = 0.7978845608028654f * (y[j] + 0.044715f * y[j] * y[j] * y[j]);
                const float th = 1.f - 2.f * __builtin_amdgcn_rcpf(1.f + __expf(2.f * u)); o[j] = 0.5f * y[j] * (1.f + th) * (j < 4 ? h0[j & 3] : h1[j & 3]); }
            v4u ow; ow.x = pk2(o[0], o[1]); ow.y = pk2(o[2], o[3]); ow.z = pk2(o[4], o[5]); ow.w = pk2(o[6], o[7]);
            if (row < nt) *(v4u*)op = ow; }
        __syncthreads();
    }
}

#ifndef ONE_LAUNCH
#define ONE_LAUNCH 1
#endif
#define INP(k) karg_ptr(8 * (k))
#ifndef DUP
#define DUP -1
#endif
__device__ __forceinline__ int nrep_of(int code) { int n = (DUP == code) ? 2 : 1; if (DUP == code) asm volatile("" : "+s"(n)); return n; }
#define NREP(code) for (int rep_ = 0, nr_ = nrep_of(code); rep_ < nr_; ++rep_)
enum { ST_INIT = 0, ST_WCONV, ST_G1, ST_S1, ST_S2, ST_S3, ST_G4, ST_G5, ST_G6, ST_FINAL, ST_FIX, ST_FIXK4, ST_FIXK6 };
__device__ __forceinline__ void make_frame(Frame& F, unsigned char* lds, int wv) {
    unsigned lb_ = (unsigned)(uintptr_t)(LAS unsigned char*)lds; asm volatile("" : "+s"(lb_));
    int g_ = gridDim.x, b_ = blockIdx.x; asm volatile("" : "+s"(g_), "+s"(b_));
    F.lds = (LAS unsigned char*)(uintptr_t)lb_; F.tid = otid(wv); F.lane = F.tid & 63; F.wave = __builtin_amdgcn_readfirstlane(F.tid >> 6); F.G = g_; F.bid = b_;
    F.out = (float*)karg_ptr(160); F.ws = (unsigned char*)karg_ptr(168);
}
template <int ST> __device__ __forceinline__ void run_stage(unsigned char* lds, int l, int half, int wv, int rep = 1) {
    Frame F; make_frame(F, lds, wv);
    unsigned char* ws = F.ws;
    bf16* hb = (bf16*)(ws + WS_HB); bf16* mg = (bf16*)(ws + WS_MG); bf16* oc = (bf16*)(ws + WS_OC); bf16* proj = (bf16*)(ws + WS_PROJ);
    unsigned long long* ssqA = (unsigned long long*)(ws + WS_SSQA); unsigned long long* ssqB = (unsigned long long*)(ws + WS_SSQB);
    const int grow0 = half * HALF_ROWS; const size_t wo = (l & 1) ? WS_WSET : 0;
    if constexpr (ST == ST_INIT) { init_phase(F, INP(0), INP(1)); }
    if constexpr (ST == ST_INIT || ST == ST_WCONV) { wconv_phase(F, l, 0, INP(3), INP(4), INP(9), INP(11), INP(14), INP(15), INP(16), INP(17), INP(18)); }
    if constexpr (ST == ST_FINAL) { final_phase(F, INP(19)); }
    if constexpr (ST == ST_FIX) { fixup_phase(F); }
    if constexpr (ST == ST_FIXK4) { fixk_phase(F, 4, ssqA); }
    if constexpr (ST == ST_FIXK6) { fixk_phase(F, 11, ssqB); }
    if constexpr (ST == ST_G1) {
                    pg8::Gemm g{(const pg8::bf16_t*)(hb + (size_t)grow0 * DMODEL), (const pg8::bf16_t*)(ws + wo + WS_WIN)};
                    typedef pg8::Order<NT_HALF, 26, 1> Ord; Ord S; S.init(F.G, F.bid);
                    pg8::EpiProj E{(pg8::bf16_t*)proj, (float*)(ws + WS_FL), ssqB, grow0};

pg8::gemm_phase<pg8::EpiProj, Ord, true, true, 1024, 1024, 0, 0>(F.lds, g, S, E, wv);
    }
    if constexpr (ST == ST_S1) {
        constexpr int N_SWA = 4 * 2 * 65, N_LRU = 4 * LRU_CH, N_CS = 4;
        NREP(32) for (int u = F.bid - 128; u >= 0 && u < N_CS; u += F.G) cumsum_unit(F, l, u, INP(6));
        NREP(30) for (int u = F.bid; u < N_SWA; u += F.G) { const int lb = u / 130, w = u % 130;
            attn_body::swa_unit(lb, w / 65, w % 65, (const attn_body::bf16*)proj, (attn_body::bf16*)oc, INP(2), INP(5) + l * 8, (char*)lds, wv); }
        NREP(31) for (int u = F.G - 1 - F.bid; u < N_LRU; u += F.G) lru_unit<0>(F, l, u / LRU_CH, u % LRU_CH, INP(7), INP(8), INP(10), INP(12), INP(13));
    }
    if constexpr (ST == ST_S2) {
        constexpr int N_LRU = 4 * LRU_CH, N_FOX = 4 * 8 * 17, N_ALL = N_LRU + N_FOX;
        unsigned* tick = (unsigned*)(ws + WS_CTL) + CW_TICK + 64 * ((l * 2 + half) * 2 + (rep & 1));
        volatile LAS unsigned* tl = (volatile LAS unsigned*)(F.lds + MISC_OFF) + 16;
#define NEXT_TICKET(t_) do { if (F.tid == 0) *tl = __hip_atomic_fetch_add(tick, 1u, __ATOMIC_RELAXED, __HIP_MEMORY_SCOPE_AGENT); __syncthreads(); t_ = (int)__builtin_amdgcn_readfirstlane(*tl); __syncthreads(); } while (0)
        int t; NEXT_TICKET(t);
        while (t < N_LRU) { lru_unit<1>(F, l, t / LRU_CH, t % LRU_CH, INP(7), INP(8), INP(10), INP(12), INP(13)); NEXT_TICKET(t); }
        while (t < N_ALL) { const int u = t - N_LRU; const int qb = 16 - u / 32, bh = u % 32, lb = bh >> 3, h = bh & 7;
            attn_body::attn_unit<16>(lb, h, qb, (const attn_body::bf16*)proj + QF_OFF, (const attn_body::bf16*)proj + KF_OFF, (const attn_body::bf16*)proj + VF_OFF, (attn_body::bf16*)oc + 512,
                                    (const float*)(ws + WS_DK) + (size_t)(lb * 8 + h) * 4352, (char*)lds, wv);
            NEXT_TICKET(t); }
#undef NEXT_TICKET
    }
    if constexpr (ST == ST_S3) {
                    pg8::Gemm g{(const pg8::bf16_t*)oc, (const pg8::bf16_t*)(ws + wo + WS_WB)};
                    typedef pg8::OrderS3 Ord; Ord S; S.init(F.G, F.bid);
                    pg8::EpiBranch E{(const pg8::bf16_t*)proj, (pg8::bf16_t*)(mg + (size_t)grow0 * DMODEL), (pg8::bf16_t*)(ws + WS_PART) + (size_t)half * 3 * 64 * 1024};

pg8::gemm_phase<pg8::EpiBranch, Ord, true, true, 512, 1536, 512, 4>(F.lds, g, S, E, wv);
    }
    if constexpr (ST == ST_G4) {
                zero_u64(F, ssqB, MP);
                pg8::Gemm g{(const pg8::bf16_t*)mg, (const pg8::bf16_t*)(ws + wo + WS_WOUT)};
                typedef pg8::OrderTailK<4> Ord; Ord S; S.init(F.G, F.bid);
                pg8::EpiRes E{F.out, (float*)(ws + WS_HMETA), (pg8::bf16_t*)hb, ssqA, (float*)(ws + WS_PARTK), (DUP == ST && rep == 0) ? 0.f : 1.f};

pg8::gemm_phase<pg8::EpiRes, Ord, true, true, 1024, 1024, 0, 0, 256>(F.lds, g, S, E, wv);
    }
    if constexpr (ST == ST_G5) {
                pg8::Gemm g{(const pg8::bf16_t*)hb, (const pg8::bf16_t*)(ws + wo + WS_WFFI)};
                typedef pg8::Order<129, 22, 1> Ord; Ord S; S.init(F.G, F.bid);
                pg8::EpiSwiglu E{(pg8::bf16_t*)proj, ssqA};

pg8::gemm_phase<pg8::EpiSwiglu, Ord, true, true, 1024, 1024, 0, 0>(F.lds, g, S, E, wv);
                if (l < 3 && rep != 0) wconv_phase(F, l + 1, 22, INP(3), INP(4), INP(9), INP(11), INP(14), INP(15), INP(16), INP(17), INP(18));
    }
    if constexpr (ST == ST_G6) {
                zero_u64(F, ssqA, MP);
                pg8::Gemm g{(const pg8::bf16_t*)proj, (const pg8::bf16_t*)(ws + wo + WS_WFFO)};
                typedef pg8::OrderTailK<11> Ord; Ord S; S.init(F.G, F.bid);
                pg8::EpiRes E{F.out, (float*)(ws + WS_HMETA), (pg8::bf16_t*)hb, ssqB, (float*)(ws + WS_PARTK), (DUP == ST && rep == 0) ? 0.f : 1.f};

pg8::gemm_phase<pg8::EpiRes, Ord, true, true, 2816, 2816, 0, 0, 256>(F.lds, g, S, E, wv);
    }
}
template <int ST> __global__ void __launch_bounds__(NWAVES * 64, 2) k_stage(Args args, int l, int half) {
    extern __shared__ __attribute__((aligned(16))) unsigned char lds[];
    run_stage<ST>(lds, l, half, __builtin_amdgcn_readfirstlane(threadIdx.x >> 6));
}

#if ONE_LAUNCH
#define RUN(ST, l_, h_) do { int nrep_ = (DUP == ST) ? 2 : 1; if (DUP == ST) asm volatile("" : "+s"(nrep_)); for (int rep_ = 0; rep_ < nrep_; ++rep_) { run_stage<ST>(lds, l_, h_, wv, (DUP == ST) ? rep_ : 1); SEAM(); } } while (0)
#define SEAM() do { XcdBarrier b_; b_.bar = (unsigned*)((unsigned char*)karg_ptr(168) + WS_CTL) + CW_BAR; { unsigned x_ = xb_xcc_id(); asm volatile("" : "+s"(x_)); b_.x = x_; } b_.st = MISC + 8; xcd_barrier(b_); } while (0)
__global__ void __launch_bounds__(NWAVES * 64, 2) fwd_kernel(Args args) {
    extern __shared__ __attribute__((aligned(16))) unsigned char lds[];
    const int wv = __builtin_amdgcn_readfirstlane(threadIdx.x >> 6);
    volatile LAS unsigned* MISC = (volatile LAS unsigned*)((LAS unsigned char*)lds + MISC_OFF);
    for (int u = threadIdx.x; u < (LDS_BYTES - RING_BYTES) / 4; u += NWAVES * 64) ((LAS unsigned*)((LAS unsigned char*)lds + RING_BYTES))[u] = 0u;
    __syncthreads();
    (void)xcd_barrier_post((unsigned*)(args.ws + WS_CTL) + CW_BAR, MISC + 8);
    run_stage<ST_INIT>(lds, 0, 0, wv);
    __threadfence(); cooperative_groups::this_grid().sync(); SEAM();
#define HALF_(l_, h_) RUN(ST_G1, l_, h_); RUN(ST_S1, l_, h_); RUN(ST_S2, l_, h_); RUN(ST_S3, l_, h_);
#define LAYER_(l_) HALF_(l_, 0) HALF_(l_, 1) RUN(ST_FIX, l_, 0); RUN(ST_G4, l_, 0); RUN(ST_FIXK4, l_, 0); RUN(ST_G5, l_, 0); RUN(ST_G6, l_, 0); RUN(ST_FIXK6, l_, 0);
    LAYER_(0) LAYER_(1) LAYER_(2) LAYER_(3)
    run_stage<ST_FINAL>(lds, 0, 0, wv);
}
#endif
template <int ST> static void launch_stage(const Args& a, int l, int half, int grid, hipStream_t stream) {
    static bool attr = false;
    if (!attr) { (void)hipFuncSetAttribute((const void*)k_stage<ST>, hipFuncAttributeMaxDynamicSharedMemorySize, LDS_BYTES); attr = true; }
    hipLaunchKernelGGL(k_stage<ST>, dim3(grid), dim3(NWAVES * 64), LDS_BYTES, stream, a, l, half);
}
extern "C" void kernel_launch(void* const* d_in, const int* in_sizes, int n_in, void* d_out, int out_size, void* d_ws, size_t ws_size, hipStream_t stream) {
    static int grid = 0;
    if (grid == 0) {
        if (n_in != 20 || out_size != 32768 * 1024 || ws_size < WS_END) { fprintf(stderr, "kernel_launch: unexpected shapes (n_in %d out %d ws %zu need %zu)\n", n_in, out_size, ws_size, (size_t)WS_END); grid = -1; return; }
        int dev = 0, cus = 0;
        (void)hipGetDevice(&dev); (void)hipDeviceGetAttribute(&cus, hipDeviceAttributeMultiprocessorCount, dev);
        grid = cus > 0 ? cus : 256;
    }
    if (grid < 0) return;
    (void)hipMemsetAsync((char*)d_ws + WS_CTL, 0, CTL_ZERO_BYTES, stream);
    Args a{};
    for (int i = 0; i < 20; ++i) a.in[i] = (const float*)d_in[i];
    a.out = (float*)d_out; a.ws = (unsigned char*)d_ws;
#if ONE_LAUNCH
    static bool attr = false;
    if (!attr) { (void)hipFuncSetAttribute((const void*)fwd_kernel, hipFuncAttributeMaxDynamicSharedMemorySize, LDS_BYTES); attr = true; }
    void* kargs[] = {&a};
    hipError_t e = hipLaunchCooperativeKernel((const void*)fwd_kernel, dim3(grid), dim3(NWAVES * 64), kargs, LDS_BYTES, stream);
    if (e != hipSuccess) fprintf(stderr, "cooperative launch failed: %s (grid %d)\n", hipGetErrorString(e), grid);
#else
    launch_stage<ST_INIT>(a, 0, 0, grid, stream);
    for (int l = 0; l < 4; ++l) {
        if (l > 0) launch_stage<ST_WCONV>(a, l, 0, grid, stream);
        for (int half = 0; half < 2; ++half) { launch_stage<ST_G1>(a, l, half, grid, stream); launch_stage<ST_S1>(a, l, half, grid, stream); launch_stage<ST_S2>(a, l, half, grid, stream); launch_stage<ST_S3>(a, l, half, grid, stream); }
        launch_stage<ST_G4>(a, l, 0, grid, stream); launch_stage<ST_G5>(a, l, 0, grid, stream); launch_stage<ST_G6>(a, l, 0, grid, stream);
    }
    launch_stage<ST_FINAL>(a, 0, 0, grid, stream);
#endif
}
```

```cpp
#include <hip/hip_runtime.h>
#include <hip/hip_cooperative_groups.h>
#include <cstdio>
#include <cstdint>
__device__ __forceinline__ int otid(int wv) { int w_ = wv; asm volatile("" : "+s"(w_)); int ln; asm volatile("v_mbcnt_lo_u32_b32 %0, -1, 0\n\tv_mbcnt_hi_u32_b32 %0, -1, %0" : "=v"(ln)); __builtin_assume(w_ >= 0 && w_ < 8); __builtin_assume(ln >= 0 && ln < 64); return w_ * 64 + ln; }
__device__ __forceinline__ float bperm_f(int srclane, float v) { return __int_as_float(__builtin_amdgcn_ds_bpermute(srclane << 2, __float_as_int(v))); }
typedef const float* cfp_t;
__device__ __forceinline__ cfp_t karg_ptr(int off) { asm volatile("" : "+s"(off)); const __attribute__((address_space(4))) char* b = (const __attribute__((address_space(4))) char*)__builtin_amdgcn_kernarg_segment_ptr(); return *(const __attribute__((address_space(4))) cfp_t*)(b + off); }
namespace pg8 {
#define PG8_LAS __attribute__((address_space(3)))
typedef unsigned short bf16_t;
typedef short bf16x8 __attribute__((ext_vector_type(8)));
typedef float f32x4 __attribute__((ext_vector_type(4)));
typedef unsigned u32x4 __attribute__((ext_vector_type(4)));
constexpr int BM = 256, BK = 64, HALF = 128, HTB = HALF * BK * 2  , STAGE_BYTES = 8 * HTB, NXCD = 8, WGM = 6;

__host__ __device__ __forceinline__ int lds_byte(int r, int c) { const int st = (r >> 4) * 2 + (c >> 5), rr = r & 15, cc = c & 31, ob = rr * 64 + cc * 2; return st * 1024 + (ob ^ (((ob >> 9) & 1) << 5)); }
__host__ __device__ __forceinline__ void stage_rc(int b, int& R, int& C) { const int st = b / 1024, sb = b % 1024, swz = sb ^ (((sb >> 9) & 1) << 5); R = (st >> 1) * 16 + swz / 64; C = (st & 1) * 32 + (swz % 64) / 2; }
__host__ __device__ __forceinline__ int perm32(int rho) { const int n = rho >> 4, i = rho & 15; return 8 * (i >> 2) + 4 * n + (i & 3); }

struct Unit { int pm, pn, g, part; };
struct Gemm { const bf16_t* A; const bf16_t* Bt; };

template <int nM, int nN, int NG> struct Order {
    static constexpr int nwg = nM * nN;
    int G, c;
    __device__ void init(int G_, int c_) { G = G_; c = c_; }
    __device__ bool next(int i, Unit& u) const {
        const int ti = (NG == 1) ? i : i / NG; u.g = (NG == 1) ? 0 : i - ti * NG; u.part = 0;
        const long L = (long)ti * G + c; if (L >= nwg) return false;
        int wgid = (int)L; { constexpr int q = nwg / NXCD, r = nwg % NXCD; const int xcd = wgid % NXCD, off = wgid / NXCD; wgid = (xcd < r ? xcd * (q + 1) : r * (q + 1) + (xcd - r) * q) + off; }
        constexpr int nig = WGM * nN; const int gid = wgid / nig, fm = gid * WGM, gsz = (nM - fm) < WGM ? (nM - fm) : WGM;
        u.pm = fm + ((wgid % nig) % gsz); u.pn = (wgid % nig) / gsz; return true;
    }
    __device__ __forceinline__ void a_ready(const Unit&) const {}
    __device__ __forceinline__ void done(const Unit&) const {}
};
struct OrderS3 {
    int G, c;
    __device__ void init(int G_, int c_) { G = G_; c = c_; }
    __device__ __forceinline__ bool next(int i, Unit& u) const {
        constexpr int nM = 64, nN = 4, nwg = nM * nN;
        const int nmain = (c < nwg) ? ((nwg - 1 - c) / G + 1) : 0;
        const bool mainu = i < 3 * nmain;
        const int ti = i / 3, gm = i - ti * 3;
        int wgid = ti * G + c; { constexpr int q = nwg / NXCD, r = nwg % NXCD; const int xcd = wgid % NXCD, off = wgid / NXCD; wgid = (xcd < r ? xcd * (q + 1) : r * (q + 1) + (xcd - r) * q) + off; }
        constexpr int nig = WGM * nN; const int gid = wgid / nig, fm = gid * WGM, gsz = (nM - fm) < WGM ? (nM - fm) : WGM;
        const int pm_m = fm + ((wgid % nig) % gsz), pn_m = (wgid % nig) / gsz;
        const int j = (i - 3 * nmain) * G + c, pn_l = j / 3, g_l = j - pn_l * 3;
        u.pm = mainu ? pm_m : 64; u.pn = mainu ? pn_m : pn_l; u.g = mainu ? gm : g_l; u.part = mainu ? 0 : 1;
        return mainu || j < 12;
    }
    __device__ __forceinline__ void a_ready(const Unit&) const {}
    __device__ __forceinline__ void done(const Unit&) const {}
};
template <int NKC> struct OrderTailK {
    int G, c;
    __device__ void init(int G_, int c_) { G = G_; c = c_; }
    __device__ __forceinline__ bool next(int i, Unit& u) const {
        constexpr int nM = 128, nN = 4, nwg = nM * nN;
        const int nmain = (c < nwg) ? ((nwg - 1 - c) / G + 1) : 0;
        const bool mainu = i < nmain;
        int wgid = i * G + c; { constexpr int q = nwg / NXCD, r = nwg % NXCD; const int xcd = wgid % NXCD, off = wgid / NXCD; wgid = (xcd < r ? xcd * (q + 1) : r * (q + 1) + (xcd - r) * q) + off; }
        constexpr int nig = WGM * nN; const int gid = wgid / nig, fm = gid * WGM, gsz = (nM - fm) < WGM ? (nM - fm) : WGM;
        const int pm_m = fm + ((wgid % nig) % gsz), pn_m = (wgid % nig) / gsz;
        const int j = (i - nmain) * G + c, pn_l = j / NKC, g_l = j - pn_l * NKC;
        u.pm = mainu ? pm_m : 128; u.pn = mainu ? pn_m : pn_l; u.g = mainu ? 0 : g_l; u.part = mainu ? 0 : 1;
        return mainu || j < 4 * NKC;
    }
    __device__ __forceinline__ void a_ready(const Unit&) const {}
    __device__ __forceinline__ void done(const Unit&) const {}
};
__device__ __forceinline__ unsigned cvt_pk_bf16(float lo, float hi) { unsigned r; asm volatile("v_cvt_pk_bf16_f32 %0, %1, %2" : "=v"(r) : "v"(lo), "v"(hi)); return r; }
__device__ __forceinline__ float bf_lo(unsigned w) { return __uint_as_float(w << 16); }
__device__ __forceinline__ float bf_hi(unsigned w) { return __uint_as_float(w & 0xffff0000u); }
__device__ __forceinline__ float sigmoid_f(float x) { return __builtin_amdgcn_rcpf(1.f + __expf(-x)); }
constexpr int M_TOK = 32896, T_TOK = 4112, NPROJ = 6656, GATE_OFF = 3328, DFF = 2816, DM = 1024, FL_LD = 16896;

#define PG8_PIN4(a, b, c, d) asm volatile("" :: "v"(a), "v"(b), "v"(c), "v"(d))
__device__ __forceinline__ float rs_of(unsigned long long q) { return rsqrtf((float)q * (1.0f / (1024.0f * 1048576.0f)) + 1e-6f); }
struct EpiProj {
    static constexpr bool PERM = true, AFTER_DRAIN = false;
    bf16_t* P; float* fl; const unsigned long long* ssq; int grow0;
    __device__ __forceinline__ void operator()(const f32x4 (&acc)[2][2][4][2], const Unit& u, int wr, int wc, int fr, int fq) const {
        const int row0 = u.pm * BM + wr * 64 + fr, col0 = u.pn * BM + wc * 32 + 8 * fq;
        unsigned long long q[2][4];
#pragma unroll
        for (int ai = 0; ai < 2; ++ai)
#pragma unroll
            for (int m = 0; m < 4; ++m) { const int grow = row0 + ai * HALF + m * 16 + grow0; q[ai][m] = ssq[grow < M_TOK ? grow : M_TOK - 1]; }
        PG8_PIN4(q[0][0], q[0][1], q[0][2], q[0][3]); PG8_PIN4(q[1][0], q[1][1], q[1][2], q[1][3]);
#pragma unroll
        for (int ai = 0; ai < 2; ++ai)
#pragma unroll
            for (int m = 0; m < 4; ++m) { const int lrow = row0 + ai * HALF + m * 16, grow = lrow + grow0;
                const float s = (grow < M_TOK) ? rs_of(q[ai][m]) : 0.f;
                if (u.pn < 25) {
#pragma unroll
                    for (int bj = 0; bj < 2; ++bj) { const f32x4 v0 = acc[ai][bj][m][0] * s, v1 = acc[ai][bj][m][1] * s;
                        u32x4 w; w.x = cvt_pk_bf16(v0[0], v0[1]); w.y = cvt_pk_bf16(v0[2], v0[3]); w.z = cvt_pk_bf16(v1[0], v1[1]); w.w = cvt_pk_bf16(v1[2], v1[3]);
                        *(u32x4*)(P + (size_t)lrow * NPROJ + col0 + bj * HALF) = w; }
                } else if (wc == 0 && fq == 0) {
                    *(f32x4*)(fl + (size_t)lrow * 8) = acc[ai][0][m][0] * s; *(f32x4*)(fl + (size_t)lrow * 8 + 4) = acc[ai][0][m][1] * s; }
            }
    }
};
struct EpiBranch {
    static constexpr bool PERM = true, AFTER_DRAIN = false;
    const bf16_t* P; bf16_t* MG; bf16_t* PART;
    __device__ __forceinline__ void operator()(const f32x4 (&acc)[2][2][4][2], const Unit& u, int wr, int wc, int fr, int fq) const {
        const int row0 = u.pm * BM + wr * 64 + fr, col0 = u.pn * BM + wc * 32 + 8 * fq;
#pragma unroll
        for (int ai = 0; ai < 2; ++ai) {
            if (u.part && (ai != 0 || wr != 0)) continue;
            u32x4 gw[4][2], pw[4][2];
#pragma unroll
            for (int m = 0; m < 4; ++m)
#pragma unroll
                for (int bj = 0; bj < 2; ++bj) { const int lrow = row0 + ai * HALF + m * 16, c = col0 + bj * HALF;
                    gw[m][bj] = *(const u32x4*)(P + (size_t)lrow * NPROJ + GATE_OFF + u.g * DM + c);
                    const u32x4 pv_ = *(const u32x4*)(MG + (size_t)lrow * DM + c);
                    pw[m][bj] = (u.g > 0 && !u.part) ? pv_ : (u32x4){0u, 0u, 0u, 0u}; }
            PG8_PIN4(gw[0][0], gw[0][1], gw[1][0], gw[1][1]); PG8_PIN4(gw[2][0], gw[2][1], gw[3][0], gw[3][1]);
            PG8_PIN4(pw[0][0], pw[0][1], pw[1][0], pw[1][1]); PG8_PIN4(pw[2][0], pw[2][1], pw[3][0], pw[3][1]);
#pragma unroll
            for (int m = 0; m < 4; ++m)
#pragma unroll
                for (int bj = 0; bj < 2; ++bj) { const int lrow = row0 + ai * HALF + m * 16, c = col0 + bj * HALF; const u32x4 g4 = gw[m][bj], p4 = pw[m][bj];
                    f32x4 v0 = acc[ai][bj][m][0], v1 = acc[ai][bj][m][1];
                    v0[0] = v0[0] * sigmoid_f(bf_lo(g4.x)) + bf_lo(p4.x); v0[1] = v0[1] * sigmoid_f(bf_hi(g4.x)) + bf_hi(p4.x); v0[2] = v0[2] * sigmoid_f(bf_lo(g4.y)) + bf_lo(p4.y); v0[3] = v0[3] * sigmoid_f(bf_hi(g4.y)) + bf_hi(p4.y);
                    v1[0] = v1[0] * sigmoid_f(bf_lo(g4.z)) + bf_lo(p4.z); v1[1] = v1[1] * sigmoid_f(bf_hi(g4.z)) + bf_hi(p4.z); v1[2] = v1[2] * sigmoid_f(bf_lo(g4.w)) + bf_lo(p4.w); v1[3] = v1[3] * sigmoid_f(bf_hi(g4.w)) + bf_hi(p4.w);
                    u32x4 w; w.x = cvt_pk_bf16(v0[0], v0[1]); w.y = cvt_pk_bf16(v0[2], v0[3]); w.z = cvt_pk_bf16(v1[0], v1[1]); w.w = cvt_pk_bf16(v1[2], v1[3]);
                    bf16_t* dst = u.part ? PART + ((size_t)u.g * 64 + (lrow - 64 * BM)) * DM + c : MG + (size_t)lrow * DM + c;
                    *(u32x4*)dst = w; }
        }
    }
};
struct EpiRes {
    static constexpr bool PERM = true, AFTER_DRAIN = false;
    float* hout; float* hmeta; bf16_t* hb; unsigned long long* ssq; float* partk; float mul;
    __device__ __forceinline__ void operator()(const f32x4 (&acc)[2][2][4][2], const Unit& u, int wr, int wc, int fr, int fq) const {
        const int row0 = u.pm * BM + wr * 64 + fr, col0 = u.pn * BM + wc * 32 + 8 * fq;
        if (u.part) {
            float* pp = partk + ((size_t)u.g * 128 + wr * 64 + fr) * DM + col0;
#pragma unroll
            for (int m = 0; m < 4; ++m)
#pragma unroll
                for (int bj = 0; bj < 2; ++bj)
#pragma unroll
                    for (int n = 0; n < 2; ++n) *(f32x4*)(pp + (size_t)m * 16 * DM + bj * HALF + n * 4) = acc[0][bj][m][n];
        } else
#pragma unroll
        for (int ai = 0; ai < 2; ++ai) {
            f32x4 hv[4][2][2]; float* hp0, *hp1, *hp2, *hp3;
#pragma unroll
            for (int m = 0; m < 4; ++m) { int grow = row0 + ai * HALF + m * 16; grow = grow < M_TOK ? grow : M_TOK - 1; const int b = grow / T_TOK, t = grow - b * T_TOK;
                float* hpm = ((t < 16) ? hmeta + (size_t)(b * 16 + t) * DM : hout + ((size_t)b * 4096 + (t - 16)) * DM) + col0;
                if (m == 0) hp0 = hpm; else if (m == 1) hp1 = hpm; else if (m == 2) hp2 = hpm; else hp3 = hpm;
#pragma unroll
                for (int bj = 0; bj < 2; ++bj)
#pragma unroll
                    for (int n = 0; n < 2; ++n) hv[m][bj][n] = *(const f32x4*)(hpm + bj * HALF + n * 4); }
#pragma unroll
            for (int m = 0; m < 4; ++m) PG8_PIN4(hv[m][0][0], hv[m][0][1], hv[m][1][0], hv[m][1][1]);
#pragma unroll
            for (int m = 0; m < 4; ++m) { const int grow = row0 + ai * HALF + m * 16; const bool ok = grow < M_TOK; float ss = 0.f; float* hpm = (m == 0) ? hp0 : (m == 1) ? hp1 : (m == 2) ? hp2 : hp3;
#pragma unroll
                for (int bj = 0; bj < 2; ++bj) { const f32x4 o0 = hv[m][bj][0] + acc[ai][bj][m][0] * mul, o1 = hv[m][bj][1] + acc[ai][bj][m][1] * mul;
                    ss += (o0[0] * o0[0] + o0[1] * o0[1]) + (o0[2] * o0[2] + o0[3] * o0[3]) + (o1[0] * o1[0] + o1[1] * o1[1]) + (o1[2] * o1[2] + o1[3] * o1[3]);
                    u32x4 w; w.x = cvt_pk_bf16(o0[0], o0[1]); w.y = cvt_pk_bf16(o0[2], o0[3]); w.z = cvt_pk_bf16(o1[0], o1[1]); w.w = cvt_pk_bf16(o1[2], o1[3]);
                    if (ok) { *(f32x4*)(hpm + bj * HALF) = o0; *(f32x4*)(hpm + bj * HALF + 4) = o1; *(u32x4*)(hb + (size_t)grow * DM + col0 + bj * HALF) = w; } }
                { const int ln_ = fq * 16 + fr; ss += bperm_f(ln_ ^ 16, ss); ss += bperm_f(ln_ ^ 32, ss); }
                if (fq == 0 && ok) atomicAdd(ssq + grow, (unsigned long long)(ss * (1048576.0f * mul)));
            }
        }
    }
};
struct EpiSwiglu {
    static constexpr bool PERM = true, AFTER_DRAIN = false;
    bf16_t* ACT; const unsigned long long* ssq;
    __device__ __forceinline__ void operator()(const f32x4 (&acc)[2][2][4][2], const Unit& u, int wr, int wc, int fr, int fq) const {
        const int row0 = u.pm * BM + wr * 64 + fr, col0 = u.pn * HALF + wc * 32 + 8 * fq;
        unsigned long long q[2][4];
#pragma unroll
        for (int ai = 0; ai < 2; ++ai)
#pragma unroll
            for (int m = 0; m < 4; ++m) { const int grow = row0 + ai * HALF + m * 16; q[ai][m] = ssq[grow < M_TOK ? grow : M_TOK - 1]; }
        PG8_PIN4(q[0][0], q[0][1], q[0][2], q[0][3]); PG8_PIN4(q[1][0], q[1][1], q[1][2], q[1][3]);
#pragma unroll
        for (int ai = 0; ai < 2; ++ai)
#pragma unroll
            for (int m = 0; m < 4; ++m) { const int grow = row0 + ai * HALF + m * 16;
                const float s = (grow < M_TOK) ? rs_of(q[ai][m]) : 0.f;
                float o[8];
#pragma unroll
                for (int n = 0; n < 2; ++n)
#pragma unroll
                    for (int j = 0; j < 4; ++j) { const float gt = acc[ai][0][m][n][j] * s, up = acc[ai][1][m][n][j] * s; o[4 * n + j] = gt * sigmoid_f(gt) * up; }
                u32x4 w; w.x = cvt_pk_bf16(o[0], o[1]); w.y = cvt_pk_bf16(o[2], o[3]); w.z = cvt_pk_bf16(o[4], o[5]); w.w = cvt_pk_bf16(o[6], o[7]);
                *(u32x4*)(ACT + (size_t)grow * DFF + col0) = w; }
    }
};

template <class Epi, class Sched, bool ALIGN_EPI, bool SP2, int GK, int LDA, int AGOFF, int BGT, int KC = 0>
__device__ __forceinline__ void gemm_phase(PG8_LAS unsigned char* lds, const Gemm g, const Sched& S, const Epi& E, int wv) {
    const int tid = otid(wv), wid = __builtin_amdgcn_readfirstlane(tid >> 6), lane = tid & 63, wr = wid >> 2, wc = wid & 3, fr = lane & 15, fq = lane >> 4;
    constexpr int K = GK, nt = K / BK;
    unsigned voffA[2], voffB[2];
#pragma unroll
    for (int i = 0; i < 2; ++i) { int R, C; stage_rc(tid * 16 + i * 8192, R, C); const int Rb = Epi::PERM ? ((R & ~31) + perm32(R & 31)) : R;
        voffA[i] = (unsigned)(R * LDA + C) * 2u; voffB[i] = (unsigned)(Rb * K + C) * 2u; }
    constexpr size_t kstep = (size_t)(BK * 2);
    constexpr size_t hstepA = (size_t)HALF * LDA * 2, hstepB = (size_t)HALF * K * 2;
    constexpr size_t tstepA = 2 * hstepA, tstepB = 2 * hstepB;
    const unsigned ldsw = (unsigned)wid * 1024u;
    const int aoff = lds_byte(wr * 64 + fr, fq * 8), boff = lds_byte(wc * 32 + fr, fq * 8);
#define PG8_SA(b, h) (((b) * 2 + (h)) * HTB)
#define PG8_SB(b, h) ((4 + (b) * 2 + (h)) * HTB)
#define PG8_STAGE(bufoff, gbase, voff) do { _Pragma("unroll") for (int _i = 0; _i < 2; ++_i) \
        __builtin_amdgcn_global_load_lds((const unsigned*)((const char*)(gbase) + (voff)[_i]), (PG8_LAS unsigned*)(lds + (bufoff) + ldsw + _i * 8192), 16, 0, 0); } while (0)
#define PG8_LDA(dst, b, h) do { _Pragma("unroll") for (int m = 0; m < 4; ++m) _Pragma("unroll") for (int k = 0; k < 2; ++k) dst[m][k] = *(const PG8_LAS bf16x8*)(lds + PG8_SA(b, h) + aoff + m * 2048 + k * 1024); } while (0)
#define PG8_LDB(dst, b, h) do { _Pragma("unroll") for (int n = 0; n < 2; ++n) _Pragma("unroll") for (int k = 0; k < 2; ++k) dst[n][k] = *(const PG8_LAS bf16x8*)(lds + PG8_SB(b, h) + boff + n * 2048 + k * 1024); } while (0)
#define PG8_MMA(ai, bj, At, Bt) do { __builtin_amdgcn_s_setprio(1); _Pragma("unroll") for (int m = 0; m < 4; ++m) _Pragma("unroll") for (int n = 0; n < 2; ++n) _Pragma("unroll") for (int k = 0; k < 2; ++k) \
        acc[ai][bj][m][n] = __builtin_amdgcn_mfma_f32_16x16x32_bf16(Bt[n][k], At[m][k], acc[ai][bj][m][n], 0, 0, 0); __builtin_amdgcn_s_setprio(0); } while (0)
#define PG8_WAIT_V(n) asm volatile("s_waitcnt vmcnt(" #n ")" ::: "memory")
#define PG8_WAIT_L(n) asm volatile("s_waitcnt lgkmcnt(" #n ")" ::: "memory")
#define PG8_BAR __builtin_amdgcn_s_barrier()
#define PG8_SCHED __builtin_amdgcn_sched_barrier(0)
    Unit cur, nxt; int ui = 0;
    if (!S.next(0, cur)) return;
    f32x4 acc[2][2][4][2];
#pragma unroll
    for (int a = 0; a < 2; ++a)
#pragma unroll
        for (int b = 0; b < 2; ++b)
#pragma unroll
            for (int m = 0; m < 4; ++m)
#pragma unroll
                for (int n = 0; n < 2; ++n) acc[a][b][m][n] = (f32x4){0.f, 0.f, 0.f, 0.f};
    bf16x8 At[4][2], B0[2][2], B1[2][2];
    const char* cA = (const char*)g.A + (size_t)cur.pm * tstepA + (size_t)cur.g * AGOFF * 2 + ((KC && cur.part) ? cur.g * (KC * 2) : 0); const char* cB = (const char*)g.Bt + (size_t)(cur.pn + cur.g * BGT) * tstepB + ((KC && cur.part) ? cur.g * (KC * 2) : 0);
    S.a_ready(cur);
    if constexpr (SP2) {
        PG8_STAGE(PG8_SB(0, 0), cB, voffB); PG8_STAGE(PG8_SB(0, 1), cB + hstepB, voffB); PG8_STAGE(PG8_SA(0, 0), cA, voffA); PG8_STAGE(PG8_SA(0, 1), cA + hstepA, voffA);
        if (wr == 1) PG8_BAR;
        PG8_WAIT_V(2); PG8_BAR;
        PG8_STAGE(PG8_SB(1, 0), cB + kstep, voffB); PG8_STAGE(PG8_SA(1, 0), cA + kstep, voffA); PG8_STAGE(PG8_SB(1, 1), cB + hstepB + kstep, voffB);
        PG8_WAIT_V(6); PG8_BAR;
    } else {
        PG8_STAGE(PG8_SB(0, 0), cB, voffB); PG8_STAGE(PG8_SA(0, 0), cA, voffA); PG8_STAGE(PG8_SB(0, 1), cB + hstepB, voffB); PG8_STAGE(PG8_SA(0, 1), cA + hstepA, voffA);
        if (wr == 1) PG8_BAR;
        PG8_WAIT_V(4); PG8_BAR;
        PG8_STAGE(PG8_SB(1, 0), cB + kstep, voffB); PG8_STAGE(PG8_SA(1, 0), cA + kstep, voffA); PG8_STAGE(PG8_SB(1, 1), cB + hstepB + kstep, voffB);
        PG8_WAIT_V(6); PG8_BAR;
    }
    for (;;) {
        const bool has_next = S.next(ui + 1, nxt);
        const char* nA = has_next ? (const char*)g.A + (size_t)nxt.pm * tstepA + (size_t)nxt.g * AGOFF * 2 + ((KC && nxt.part) ? nxt.g * (KC * 2) : 0) : cA; const char* nB = has_next ? (const char*)g.Bt + (size_t)(nxt.pn + nxt.g * BGT) * tstepB + ((KC && nxt.part) ? nxt.g * (KC * 2) : 0) : cB;
        const int ntu = (KC && cur.part) ? KC / BK : nt;
        for (int t = 0; t < ntu; t += 2) {
            const bool last = (t == ntu - 2);
            const char* a1 = cA + (size_t)(t + 1) * kstep;
            const char* a2 = last ? nA : cA + (size_t)(t + 2) * kstep; const char* b2 = last ? nB : cB + (size_t)(t + 2) * kstep;
            const char* a3 = a2 + kstep; const char* b3 = b2 + kstep;
            if (last && has_next) S.a_ready(nxt);
            if constexpr (SP2) {
            PG8_LDB(B0, 0, 0); PG8_LDB(B1, 0, 1); PG8_SCHED; PG8_LDA(At, 0, 0); PG8_STAGE(PG8_SA(1, 1), a1 + hstepA, voffA);
            PG8_WAIT_V(8); PG8_WAIT_L(0); PG8_BAR; PG8_MMA(0, 0, At, B0); PG8_MMA(0, 1, At, B1); PG8_BAR; PG8_SCHED;
            PG8_LDA(At, 0, 1); PG8_STAGE(PG8_SB(0, 0), b2, voffB); PG8_STAGE(PG8_SB(0, 1), b2 + hstepB, voffB); PG8_STAGE(PG8_SA(0, 0), a2, voffA);
            PG8_WAIT_V(8); PG8_WAIT_L(0); PG8_BAR; PG8_MMA(1, 0, At, B0); PG8_MMA(1, 1, At, B1); PG8_BAR; PG8_SCHED;
            PG8_LDB(B0, 1, 0); PG8_LDB(B1, 1, 1); PG8_SCHED; PG8_LDA(At, 1, 0); PG8_STAGE(PG8_SA(0, 1), a2 + hstepA, voffA);
            PG8_WAIT_V(8); PG8_WAIT_L(0); PG8_BAR; PG8_MMA(0, 0, At, B0); PG8_MMA(0, 1, At, B1); PG8_BAR; PG8_SCHED;
            PG8_LDA(At, 1, 1); PG8_STAGE(PG8_SB(1, 0), b3, voffB); PG8_STAGE(PG8_SB(1, 1), b3 + hstepB, voffB); PG8_STAGE(PG8_SA(1, 0), a3, voffA);
            PG8_WAIT_V(8); PG8_WAIT_L(0); PG8_BAR; PG8_MMA(1, 0, At, B0); PG8_MMA(1, 1, At, B1); PG8_BAR; PG8_SCHED;
            } else {
            PG8_LDB(B0, 0, 0); PG8_SCHED; PG8_LDA(At, 0, 0); PG8_STAGE(PG8_SA(1, 1), a1 + hstepA, voffA);
            PG8_WAIT_L(8); PG8_BAR; PG8_WAIT_L(0); PG8_MMA(0, 0, At, B0); PG8_BAR; PG8_SCHED;
            PG8_LDB(B1, 0, 1); PG8_STAGE(PG8_SB(0, 0), b2, voffB);
            PG8_BAR; PG8_WAIT_L(0); PG8_MMA(0, 1, At, B1); PG8_BAR;
            PG8_LDA(At, 0, 1); PG8_STAGE(PG8_SA(0, 0), a2, voffA);
            PG8_BAR; PG8_WAIT_L(0); PG8_MMA(1, 0, At, B0); PG8_BAR; PG8_SCHED;
            PG8_STAGE(PG8_SB(0, 1), b2 + hstepB, voffB);
            PG8_WAIT_V(6); PG8_BAR; PG8_MMA(1, 1, At, B1); PG8_BAR;
            PG8_LDB(B0, 1, 0); PG8_SCHED; PG8_LDA(At, 1, 0); PG8_STAGE(PG8_SA(0, 1), a2 + hstepA, voffA);
            PG8_WAIT_L(8); PG8_BAR; PG8_WAIT_L(0); PG8_MMA(0, 0, At, B0); PG8_BAR; PG8_SCHED;
            PG8_LDB(B1, 1, 1); PG8_STAGE(PG8_SB(1, 0), b3, voffB);
            PG8_BAR; PG8_WAIT_L(0); PG8_MMA(0, 1, At, B1); PG8_BAR;
            PG8_LDA(At, 1, 1); PG8_STAGE(PG8_SA(1, 0), a3, voffA);
            PG8_BAR; PG8_WAIT_L(0); PG8_MMA(1, 0, At, B0); PG8_BAR; PG8_SCHED;
            PG8_STAGE(PG8_SB(1, 1), b3 + hstepB, voffB);
            PG8_WAIT_V(6); PG8_BAR; PG8_MMA(1, 1, At, B1); PG8_BAR;
            }
        }
        if constexpr (ALIGN_EPI) { if (wr == 0) PG8_BAR; }
        if constexpr (!Epi::AFTER_DRAIN) { E(acc, cur, wr, wc, fr, fq); S.done(cur); }
        if (!has_next) break;
#pragma unroll
        for (int a = 0; a < 2; ++a)
#pragma unroll
            for (int b = 0; b < 2; ++b)
#pragma unroll
                for (int m = 0; m < 4; ++m)
#pragma unroll
                    for (int n = 0; n < 2; ++n) acc[a][b][m][n] = (f32x4){0.f, 0.f, 0.f, 0.f};
        cur = nxt; cA = nA; cB = nB; ++ui;
        if constexpr (ALIGN_EPI) { if (wr == 1) PG8_BAR; }
    }
    PG8_WAIT_V(0);
    if constexpr (!ALIGN_EPI) { if (wr == 0) PG8_BAR; }
    PG8_BAR;
    if constexpr (Epi::AFTER_DRAIN) { E.fused(acc, cur, wr, wc, fr, fq, lds, wid, lane); S.done(cur); }
#undef PG8_SA
#undef PG8_SB
#undef PG8_STAGE
#undef PG8_LDA
#undef PG8_LDB
#undef PG8_MMA
#undef PG8_WAIT_V
#undef PG8_WAIT_L
#undef PG8_BAR
#undef PG8_SCHED
}
}

#include <hip/hip_bf16.h>
#include <cmath>
namespace attn_body {
using bf16=__hip_bfloat16;
using bf16x8=__attribute__((ext_vector_type(8)))short;
using s16x4=__attribute__((ext_vector_type(4)))short;
using f32x16=__attribute__((ext_vector_type(16)))float;
using u32x4=__attribute__((ext_vector_type(4)))unsigned;
constexpr int D=64,PQ=6656,PO=1536,TTOK=4112;
constexpr int NW=8,QBLK=32,QB=QBLK*NW,KVBLK=64,NQB=17;
__device__ __forceinline__ int crow(int r,int hi){return (r&3)+8*(r>>2)+4*hi;}
#define SBAR() __builtin_amdgcn_sched_barrier(0)
__device__ __forceinline__ void cmask(f32x16&p0,f32x16&p1,int jb,int qrel,int hi){
  const float NEG=-INFINITY; int kb=64*jb+4*hi;
  #pragma unroll
  for(int r=0;r<16;++r){int kv=kb+(r&3)+8*(r>>2); if(kv>qrel)p0[r]=NEG; if(kv+32>qrel)p1[r]=NEG;}
}

constexpr int NSLOT=3, SLOTB=8192;
constexpr int LDS_K=0, LDS_V=NSLOT*SLOTB, LDS_WS=2*NSLOT*SLOTB, LDS_OST=LDS_WS+NW*64*4, LDS_BYTES=LDS_OST+NW*4096, LDS_DK=LDS_BYTES, LDS_END=LDS_DK+66*256;
constexpr float C2=0.125f*1.4426950408889634f;
__device__ __forceinline__ void glds16(const void*gsrc,unsigned lds_dst){unsigned keep;
  asm volatile("s_mov_b32 %0, m0\n\ts_mov_b32 m0, %2\n\ts_nop 0\n\tglobal_load_lds_dwordx4 %1, off\n\ts_mov_b32 m0, %0":"=&s"(keep):"v"(gsrc),"s"(lds_dst):"memory");}
__device__ __forceinline__ float max3f(float a,float b,float c){float r;asm("v_max3_f32 %0, %1, %2, %3":"=v"(r):"v"(a),"v"(b),"v"(c));return r;}
__device__ __forceinline__ float max2f(float a,float b){float r;asm("v_max_f32_e32 %0, %1, %2":"=v"(r):"v"(a),"v"(b));return r;}
__device__ __forceinline__ float fadd_s(float a,float b){float r;asm("v_add_f32_e32 %0, %1, %2":"=v"(r):"v"(a),"v"(b));return r;}
__device__ __forceinline__ float fsub_s(float a,float b){float r;asm("v_sub_f32_e32 %0, %1, %2":"=v"(r):"v"(a),"v"(b));return r;}
typedef float f32x2_t __attribute__((ext_vector_type(2))); typedef __bf16 bf16x2_t __attribute__((ext_vector_type(2)));
__device__ __forceinline__ unsigned cvtpk_s(float lo,float hi){f32x2_t v={lo,hi};bf16x2_t b=__builtin_convertvector(v,bf16x2_t);return __builtin_bit_cast(unsigned,b);}
#define WAIT_BAR(N) asm volatile("s_waitcnt vmcnt(" #N ") lgkmcnt(0)\n\ts_barrier":::"memory")

__device__ __forceinline__ void qkt(f32x16&p0,f32x16&p1,const char*Kslot,const bf16x8*qr,const f32x16&negm,int r32,int hi){
  const char*kb=Kslot+hi*1024+r32*16;
  #pragma unroll
  for(int d0=0;d0<4;++d0){
    const bf16x8 b0=*reinterpret_cast<const bf16x8*>(kb+d0*2048);
    const bf16x8 b1=*reinterpret_cast<const bf16x8*>(kb+d0*2048+512);
    if(d0==0){p0=__builtin_amdgcn_mfma_f32_32x32x16_bf16(b0,qr[0],negm,0,0,0);p1=__builtin_amdgcn_mfma_f32_32x32x16_bf16(b1,qr[0],negm,0,0,0);}
    else{p0=__builtin_amdgcn_mfma_f32_32x32x16_bf16(b0,qr[d0],p0,0,0,0);p1=__builtin_amdgcn_mfma_f32_32x32x16_bf16(b1,qr[d0],p1,0,0,0);}}
}
typedef __attribute__((address_space(3))) const char* lds_cptr;
typedef short v4i16_t __attribute__((ext_vector_type(4)));
__device__ __forceinline__ void kload8(bf16x8*kf,lds_cptr kp){
  kf[0]=*(const __attribute__((address_space(3))) bf16x8*)(kp);      kf[1]=*(const __attribute__((address_space(3))) bf16x8*)(kp+512);
  kf[2]=*(const __attribute__((address_space(3))) bf16x8*)(kp+2048); kf[3]=*(const __attribute__((address_space(3))) bf16x8*)(kp+2560);
  kf[4]=*(const __attribute__((address_space(3))) bf16x8*)(kp+4096); kf[5]=*(const __attribute__((address_space(3))) bf16x8*)(kp+4608);
  kf[6]=*(const __attribute__((address_space(3))) bf16x8*)(kp+6144); kf[7]=*(const __attribute__((address_space(3))) bf16x8*)(kp+6656);
}
__device__ __forceinline__ void kload2(bf16x8*kf,lds_cptr kp,int j){ kf[2*j]=*(const __attribute__((address_space(3))) bf16x8*)(kp+j*2048); kf[2*j+1]=*(const __attribute__((address_space(3))) bf16x8*)(kp+j*2048+512); }
__device__ __forceinline__ s16x4 vtr(lds_cptr p){ return __builtin_bit_cast(s16x4,__builtin_amdgcn_ds_read_tr16_b64_v4i16((__attribute__((address_space(3))) v4i16_t*)p)); }
__device__ __forceinline__ float rowmax(const f32x16&p0,const f32x16&p1){
  float a=max3f(p0[0],p0[1],p1[0]),b=max3f(p0[2],p0[3],p1[1]);a=max3f(a,p1[2],p1[3]);
  #pragma unroll
  for(int r=4;r<16;r+=4){a=max3f(a,p0[r],p0[r+1]);b=max3f(b,p0[r+2],p0[r+3]);a=max3f(a,p1[r],p1[r+1]);b=max3f(b,p1[r+2],p1[r+3]);}
  const float m=max2f(a,b);
  auto rr=__builtin_amdgcn_permlane32_swap(__float_as_uint(m),__float_as_uint(m),false,false);
  return max2f(__uint_as_float(rr[0]),__uint_as_float(rr[1]));
}
__device__ __forceinline__ void pv(f32x16*o,int vb,bf16x8 pa0,bf16x8 pa1,bf16x8 pa2,bf16x8 pa3){
  #pragma unroll
  for(int d0=0;d0<2;++d0){s16x4 lo[4],hi[4];
    #pragma unroll
    for(int ks=0;ks<4;++ks){
      asm volatile("ds_read_b64_tr_b16 %0,%1 offset:%c2":"=&v"(lo[ks]):"v"(vb),"i"(d0*4096+ks*1024):"memory");
      asm volatile("ds_read_b64_tr_b16 %0,%1 offset:%c2":"=&v"(hi[ks]):"v"(vb),"i"(d0*4096+ks*1024+512):"memory");}
    asm volatile("s_waitcnt lgkmcnt(0)":::"memory");SBAR();
    #define PK(k) (bf16x8){lo[k][0],lo[k][1],lo[k][2],lo[k][3],hi[k][0],hi[k][1],hi[k][2],hi[k][3]}
    o[d0]=__builtin_amdgcn_mfma_f32_32x32x16_bf16(pa0,PK(0),o[d0],0,0,0);
    o[d0]=__builtin_amdgcn_mfma_f32_32x32x16_bf16(pa1,PK(1),o[d0],0,0,0);
    o[d0]=__builtin_amdgcn_mfma_f32_32x32x16_bf16(pa2,PK(2),o[d0],0,0,0);
    o[d0]=__builtin_amdgcn_mfma_f32_32x32x16_bf16(pa3,PK(3),o[d0],0,0,0);
    #undef PK
  }
}

#ifndef ATTN_STORE16
#define ATTN_STORE16(p,v) (*(u32x4*)(p)=(v))
#endif
template<int THRL> __device__ __forceinline__ void attn_unit(int b,int h,int qb,const bf16*Q,const bf16*__restrict__ K,const bf16*__restrict__ V,bf16*O,const float*__restrict__ dkg,char*shm,int wv){
  const int tid=otid(wv),lane=tid&63,r32=lane&31,hi=lane>>5; const int wid=__builtin_amdgcn_readfirstlane(tid>>6);
  const long rowbase=(long)b*TTOK; const int q0=qb*QB;
  const bf16*Qw=Q+(rowbase+q0+wid*QBLK)*PQ+h*D;
  const bf16*Kh=K+rowbase*PQ+h*D,*Vh=V+rowbase*PQ+h*D;
  const unsigned lds0=(unsigned)(uintptr_t)shm;
  float*wsf=(float*)(shm+LDS_WS)+wid*64;
  const bf16*ksrc=Kh+(long)lane*PQ+wid*8;
  const bf16*vsrc=Vh+(long)(16*(wid&3)+(lane>>2))*PQ+(wid>>2)*32+(lane&3)*8;
  const unsigned kdst=lds0+LDS_K+wid*1024, vdst=lds0+LDS_V+wid*1024;
  #define DMA_K(t,slot) glds16(ksrc+(long)(t)*KVBLK*PQ,(unsigned)__builtin_amdgcn_readfirstlane(kdst+(slot)))
  #define DMA_V(t,slot) glds16(vsrc+(long)(t)*KVBLK*PQ,(unsigned)__builtin_amdgcn_readfirstlane(vdst+(slot)))
  const int vb0=(int)(lds0+LDS_V)+((lane>>4)&1)*32+(lane&3)*8+(4*hi+((lane&15)>>2))*64;
  const char*Kbase=shm+LDS_K; bf16x8 kf[8];
  const lds_cptr shm3=(lds_cptr)shm; const lds_cptr kp0=shm3+LDS_K+hi*1024+r32*16; const lds_cptr vp0=shm3+LDS_V+((lane>>4)&1)*32+(lane&3)*8+(4*hi+((lane&15)>>2))*64;
  const int NT=(qb==NQB-1)?66:(q0+QB)/KVBLK; const int band0=4*qb;
  { typedef float f4_t __attribute__((ext_vector_type(4)));
    for(int i_=tid;i_<NT*16;i_+=NW*64){ const f4_t v_=*(const f4_t*)(dkg+4*i_); *(__attribute__((address_space(3))) f4_t*)(shm3+LDS_DK+16*i_)=v_; } }
  #define ADDK(P0,P1,t) do{ typedef float f4_t __attribute__((ext_vector_type(4))); const __attribute__((address_space(3))) f4_t* dq_=(const __attribute__((address_space(3))) f4_t*)(shm3+LDS_DK+(t)*256+hi*16); \
    _Pragma("unroll") for(int g_=0;g_<4;++g_){ const f4_t a_=dq_[2*g_], b_=dq_[8+2*g_]; \
      P0[4*g_]+=a_[0];P0[4*g_+1]+=a_[1];P0[4*g_+2]+=a_[2];P0[4*g_+3]+=a_[3]; P1[4*g_]+=b_[0];P1[4*g_+1]+=b_[1];P1[4*g_+2]+=b_[2];P1[4*g_+3]+=b_[3]; } }while(0)
  DMA_K(0,0);DMA_V(0,0);DMA_K(1,SLOTB);
  bf16x8 qr[4];
  #pragma unroll
  for(int d0=0;d0<4;++d0)qr[d0]=*reinterpret_cast<const bf16x8*>(&Qw[(long)r32*PQ+d0*16+hi*8]);
  const lds_cptr qpark=shm3+LDS_OST+wid*4096+lane*16;
  #pragma unroll
  for(int d0=0;d0<4;++d0)*(__attribute__((address_space(3))) bf16x8*)(qpark+d0*1024)=qr[d0];
  #define QP(k) (*(const __attribute__((address_space(3))) bf16x8*)(qpark+(k)*1024))
  float mhat=0.f,l_reg=0.f;f32x16 o[2];o[0]=f32x16{};o[1]=f32x16{};f32x16 negm=f32x16{};asm volatile("":"+v"(negm));
  const int qrel=wid*QBLK+r32;
  #define CMASK(P0,P1,t) do{int jb_=(t)-band0; if(jb_>=0)cmask(P0,P1,jb_,qrel,hi);}while(0)
  bool resc=false;
  #define START(P0,P1) do{ const float rm=rowmax(P0,P1); resc=false; \
    { const float dl=rm; mhat=fadd_s(mhat,dl); \
      _Pragma("unroll") for(int r=0;r<16;++r){P0[r]=fsub_s(P0[r],dl);P1[r]=fsub_s(P1[r],dl);} \
      _Pragma("unroll") for(int r=0;r<16;++r)negm[r]=-mhat; asm volatile("":"+v"(negm)); \
       } \
    _Pragma("unroll") for(int r=0;r<16;++r)P0[r]=__builtin_amdgcn_exp2f(P0[r]); }while(0)
  #define RESC() do{ if(resc){ asm volatile("s_waitcnt lgkmcnt(0)":::"memory"); \
      _Pragma("unroll") for(int d_=0;d_<2;++d_) _Pragma("unroll") for(int r=0;r<16;++r)o[d_][r]*=wsf[crow(r,hi)]; } }while(0)
  f32x16 pA0,pA1,pB0,pB1;
  int sl_prev=0,sl_cur=0,sl_next=SLOTB;
  #define ROT() do{sl_prev=sl_cur;sl_cur=sl_next;sl_next=(sl_next==(NSLOT-1)*SLOTB)?0:sl_next+SLOTB;}while(0)
  DMA_K(2,2*SLOTB);
  WAIT_BAR(3);
  { const f32x16 zc_=f32x16{}; qkt(pA0,pA1,Kbase,qr,zc_,r32,hi); }asm volatile("s_nop 15\n\ts_nop 7":"+v"(pA0),"+v"(pA1));ADDK(pA0,pA1,0);CMASK(pA0,pA1,0);
  START(pA0,pA1);
  _Pragma("unroll") for(int r=0;r<16;++r)pA1[r]=__builtin_amdgcn_exp2f(pA1[r]);
  WAIT_BAR(0);
  DMA_K(3,0);DMA_V(1,SLOTB);
  ROT();
  kload8(kf,kp0+sl_cur);
  WAIT_BAR(2);
  s16x4 vlo[8],vhi[8]; u32x4 pw0,pw1,pw2,pw3;
  #define PKW(P,B) cvtpk_s(P[B],P[B+1])
  #define PAF(k) __builtin_bit_cast(bf16x8,pw##k)
  #define VFR(i) (bf16x8){vlo[i][0],vlo[i][1],vlo[i][2],vlo[i][3],vhi[i][0],vhi[i][1],vhi[i][2],vhi[i][3]}
  #define PIN(x) asm volatile("":"+v"(x))
  #define MX3(a,b,c) __builtin_fmaxf(__builtin_fmaxf((a),(b)),(c))
  #define GAPA(MF,A0,A1,A2,A3,W0,W1,PW) do{ MF; sacc+=A0; sacc+=A1; sacc+=A2; sacc+=A3; PIN(sacc); W0; W1; PIN(PW); SBAR(); }while(0)
  #define EX(v) __builtin_amdgcn_exp2f(v)
  #define GAPB(MF,X,B) do{ MF; X[B]=EX(X[B]); X[B+1]=EX(X[B+1]); X[B+2]=EX(X[B+2]); X[B+3]=EX(X[B+3]); PIN(X); SBAR(); }while(0)
  #define VRD(i) do{ vlo[i]=vtr(vp_+(((i)>>2)*4096+((i)&3)*1024)); vhi[i]=vtr(vp_+(((i)>>2)*4096+((i)&3)*1024+512)); }while(0)
  #define KRD(G,j) do{ if(G){ kload2(kf,kp0+sl_next,j); SBAR(); } }while(0)
  #define STEP(C0,C1,P0,P1,t,GK,GV,GL) do{ SBAR(); \
    const lds_cptr vp_=vp0+sl_prev; \
    bf16x8 qa_=QP(0),qb_=QP(1); VRD(0); SBAR(); float sacc=(P0[0]+P0[1]); \
    GAPA(C0=__builtin_amdgcn_mfma_f32_32x32x16_bf16(kf[0],qa_,negm,0,0,0), P0[2],P0[3],P0[4],P0[5],     pw0[0]=PKW(P0,0), pw0[1]=PKW(P0,2), pw0); \
    VRD(4); SBAR(); GAPA(C1=__builtin_amdgcn_mfma_f32_32x32x16_bf16(kf[1],qa_,negm,0,0,0), P0[6],P0[7],P0[8],P0[9],     pw0[2]=PKW(P0,4), pw0[3]=PKW(P0,6), pw0); \
    qa_=QP(2); VRD(1); SBAR(); GAPA(C0=__builtin_amdgcn_mfma_f32_32x32x16_bf16(kf[2],qb_,C0,0,0,0),   P0[10],P0[11],P0[12],P0[13], pw1[0]=PKW(P0,8), pw1[1]=PKW(P0,10), pw1); \
    VRD(5); SBAR(); GAPA(C1=__builtin_amdgcn_mfma_f32_32x32x16_bf16(kf[3],qb_,C1,0,0,0),   P0[14],P0[15],P1[0],P1[1],   pw1[2]=PKW(P0,12),pw1[3]=PKW(P0,14), pw1); \
    qb_=QP(3); VRD(2); SBAR(); GAPA(C0=__builtin_amdgcn_mfma_f32_32x32x16_bf16(kf[4],qa_,C0,0,0,0),   P1[2],P1[3],P1[4],P1[5],     pw2[0]=PKW(P1,0), pw2[1]=PKW(P1,2), pw2); \
    VRD(6); SBAR(); GAPA(C1=__builtin_amdgcn_mfma_f32_32x32x16_bf16(kf[5],qa_,C1,0,0,0),   P1[6],P1[7],P1[8],P1[9],     pw2[2]=PKW(P1,4), pw2[3]=PKW(P1,6), pw2); \
    VRD(3); SBAR(); GAPA(C0=__builtin_amdgcn_mfma_f32_32x32x16_bf16(kf[6],qb_,C0,0,0,0),   P1[10],P1[11],P1[12],P1[13], pw3[0]=PKW(P1,8), pw3[1]=PKW(P1,10), pw3); \
    VRD(7); SBAR(); GAPA(C1=__builtin_amdgcn_mfma_f32_32x32x16_bf16(kf[7],qb_,C1,0,0,0),   P1[14],P1[15],0.f,0.f,       pw3[2]=PKW(P1,12),pw3[3]=PKW(P1,14), pw3); \
    l_reg+=sacc; \
    if(GK){DMA_K((t)+3,sl_cur);} if(GV){DMA_V((t)+1,sl_next);} \
    ADDK(C0,C1,t); CMASK(C0,C1,t); \
    { float a=MX3(C0[0],C0[1],C1[0]),b=MX3(C0[2],C0[3],C1[1]); a=MX3(a,C1[2],C1[3]); \
      _Pragma("unroll") for(int r=4;r<16;r+=4){a=MX3(a,C0[r],C0[r+1]);b=MX3(b,C0[r+2],C0[r+3]);a=MX3(a,C1[r],C1[r+1]);b=MX3(b,C1[r+2],C1[r+3]);} \
      float rm=__builtin_fmaxf(a,b); { auto rr=__builtin_amdgcn_permlane32_swap(__float_as_uint(rm),__float_as_uint(rm),false,false); rm=__builtin_fmaxf(__uint_as_float(rr[0]),__uint_as_float(rr[1])); } \
      resc=false; \
      if(__builtin_expect(__any(rm>(float)THRL),0)){ const float dl=__builtin_fmaxf(rm,0.f); mhat+=dl; \
        _Pragma("unroll") for(int r=0;r<16;++r){C0[r]-=dl;C1[r]-=dl;} \
        _Pragma("unroll") for(int r=0;r<16;++r)negm[r]=-mhat; asm volatile("":"+v"(negm)); \
         \
        const float f=__builtin_amdgcn_exp2f(-dl); l_reg*=f; if(hi==0)wsf[r32]=f; resc=true; } } \
    SBAR(); \
    GAPB(o[0]=__builtin_amdgcn_mfma_f32_32x32x16_bf16(PAF(0),VFR(0),o[0],0,0,0), C0,0); \
    GAPB(o[1]=__builtin_amdgcn_mfma_f32_32x32x16_bf16(PAF(0),VFR(4),o[1],0,0,0), C0,4); \
    KRD(GL,0); GAPB(o[0]=__builtin_amdgcn_mfma_f32_32x32x16_bf16(PAF(1),VFR(1),o[0],0,0,0), C0,8); \
    KRD(GL,1); GAPB(o[1]=__builtin_amdgcn_mfma_f32_32x32x16_bf16(PAF(1),VFR(5),o[1],0,0,0), C0,12); \
    KRD(GL,2); GAPB(o[0]=__builtin_amdgcn_mfma_f32_32x32x16_bf16(PAF(2),VFR(2),o[0],0,0,0), C1,0); \
    KRD(GL,3); GAPB(o[1]=__builtin_amdgcn_mfma_f32_32x32x16_bf16(PAF(2),VFR(6),o[1],0,0,0), C1,4); \
    GAPB(o[0]=__builtin_amdgcn_mfma_f32_32x32x16_bf16(PAF(3),VFR(3),o[0],0,0,0), C1,8); \
    GAPB(o[1]=__builtin_amdgcn_mfma_f32_32x32x16_bf16(PAF(3),VFR(7),o[1],0,0,0), C1,12); \
    }while(0)
  int t=1;
  #undef CMASK
  #define CMASK(P0,P1,t) do{}while(0)
  for(;t+5<NT;t+=2){
    STEP(pB0,pB1,pA0,pA1,t,true,true,true);     WAIT_BAR(2); RESC(); ROT();
    STEP(pA0,pA1,pB0,pB1,t+1,true,true,true);   WAIT_BAR(2); RESC(); ROT();
  }
  #undef CMASK
  #define CMASK(P0,P1,t) do{int jb_=(t)-band0; if(jb_>=0)cmask(P0,P1,jb_,qrel,hi);}while(0)
  #define ENDW(tt) do{ if((tt)+3<NT){WAIT_BAR(2);} else if((tt)+2<NT){WAIT_BAR(1);} else {WAIT_BAR(0);} }while(0)
  for(;t+1<NT;t+=2){
    STEP(pB0,pB1,pA0,pA1,t,(t+3<NT),(t+1<NT),(t+1<NT));       ENDW(t);   RESC(); ROT();
    STEP(pA0,pA1,pB0,pB1,t+1,(t+4<NT),(t+2<NT),(t+2<NT));     ENDW(t+1); RESC(); ROT();
  }
  STEP(pB0,pB1,pA0,pA1,NT-1,false,false,false); RESC();
  { float sacc=pB0[0]+pB0[1]; _Pragma("unroll") for(int r=2;r<16;++r)sacc+=pB0[r]; _Pragma("unroll") for(int r=0;r<16;++r)sacc+=pB1[r]; l_reg+=sacc;
    pw0=(u32x4){PKW(pB0,0),PKW(pB0,2),PKW(pB0,4),PKW(pB0,6)};pw1=(u32x4){PKW(pB0,8),PKW(pB0,10),PKW(pB0,12),PKW(pB0,14)};pw2=(u32x4){PKW(pB1,0),PKW(pB1,2),PKW(pB1,4),PKW(pB1,6)};pw3=(u32x4){PKW(pB1,8),PKW(pB1,10),PKW(pB1,12),PKW(pB1,14)};
    SBAR(); pv(o,vb0+sl_cur,PAF(0),PAF(1),PAF(2),PAF(3)); }
  #undef PKW
  #undef PAF
  #undef VFR
  #undef PIN
  #undef MX3
  #undef GAPA
  #undef GAPB
  #undef EX
  #undef VRD
  #undef KRD
  #undef STEP
  #undef ENDW
  {auto rr=__builtin_amdgcn_permlane32_swap(__float_as_uint(l_reg),__float_as_uint(l_reg),false,false);l_reg=__uint_as_float(rr[0])+__uint_as_float(rr[1]);}
  if(hi==0)wsf[32+r32]=l_reg;asm volatile("s_waitcnt lgkmcnt(0)":::"memory");
  float rli[16];
  #pragma unroll
  for(int r=0;r<16;++r)rli[r]=__builtin_amdgcn_rcpf(wsf[32+crow(r,hi)]);
  bf16*Ow=O+(rowbase+q0+wid*QBLK)*PO+h*D;
  { bf16*stg=(bf16*)(shm+LDS_OST)+wid*2048;
    #pragma unroll
    for(int r=0;r<16;++r){const int orow=crow(r,hi);
      #pragma unroll
      for(int d0=0;d0<2;++d0)stg[orow*64+d0*32+r32]=__float2bfloat16(o[d0][r]*rli[r]);}
    asm volatile("s_waitcnt lgkmcnt(0)":::"memory");
    #pragma unroll
    for(int i=0;i<4;++i){const int row=i*8+(lane>>3),ch=lane&7; const u32x4 v=*(const u32x4*)(stg+row*64+ch*8); if(q0+wid*QBLK+row<TTOK)ATTN_STORE16(Ow+(long)row*PO+ch*8,v);} }
  asm volatile("s_waitcnt lgkmcnt(0)\n\ts_barrier":::"memory");
  #undef ADDK
  #undef QP
  #undef DMA_K
  #undef DMA_V
  #undef CMASK
  #undef START
  #undef RESC
  #undef ROT
}
constexpr int QA_OFF=0,KA_OFF=512,VA_OFF=640;
__device__ __forceinline__ void swa_unit(int lb,int kvh,int a,const bf16*__restrict__ P,bf16*OC,const float*__restrict__ rel,const float*__restrict__ sinks,char*shm,int wv){
  const int tid=otid(wv),lane=tid&63,r32=lane&31,hi=lane>>5; const int wid=__builtin_amdgcn_readfirstlane(tid>>6);
  const int g=wid>>1,half=wid&1,hq=kvh*4+g;
  const long rowbase=(long)lb*TTOK;
  const unsigned lds0=(unsigned)(uintptr_t)shm; const lds_cptr shm3=(lds_cptr)shm;
  float*wsf=(float*)(shm+LDS_WS)+wid*64;
  const float LOG2E=1.4426950408889634f;
  { const int gg=tid>>7,d=tid&127; int bk=d; if(d>=16){ bk=16+(int)(logf((float)d*(1.f/16.f))*(16.f/2.0794415416798357f)); if(bk>31)bk=31; }
    ((__attribute__((address_space(3))) float*)(shm3+LDS_DK))[tid]=rel[bk*8+kvh*4+gg]*LOG2E; }
  const int t_lo=a>=2?a-2:0; const int ntile=a-t_lo+1;
  const bf16*Kh=P+rowbase*PQ+KA_OFF+kvh*64,*Vh=P+rowbase*PQ+VA_OFF+kvh*64;
  const bf16*ksrc=Kh+(long)lane*PQ+wid*8;
  const bf16*vsrc=Vh+(long)(16*(wid&3)+(lane>>2))*PQ+(wid>>2)*32+(lane&3)*8;
  #pragma unroll
  for(int j=0;j<3;++j) if(j<ntile){
    glds16(ksrc+(long)(t_lo+j)*KVBLK*PQ,(unsigned)__builtin_amdgcn_readfirstlane(lds0+LDS_K+wid*1024+j*SLOTB));
    glds16(vsrc+(long)(t_lo+j)*KVBLK*PQ,(unsigned)__builtin_amdgcn_readfirstlane(lds0+LDS_V+wid*1024+j*SLOTB)); }
  const int qpos=64*a+32*half+r32;
  const bf16*Qw=P+(rowbase+64*a+32*half)*PQ+QA_OFF+hq*64;
  bf16x8 qr[4];
  #pragma unroll
  for(int d0=0;d0<4;++d0)qr[d0]=*reinterpret_cast<const bf16x8*>(&Qw[(long)r32*PQ+d0*16+hi*8]);
  const float sink2=sinks[hq]*LOG2E;
  asm volatile("s_waitcnt vmcnt(0) lgkmcnt(0)\n\ts_barrier":::"memory");
  f32x16 S0[3],S1[3]; f32x16 zero=f32x16{};
  #pragma unroll
  for(int j=0;j<3;++j){ S0[j]=f32x16{}; S1[j]=f32x16{}; if(j<ntile){ qkt(S0[j],S1[j],shm+LDS_K+j*SLOTB,qr,zero,r32,hi); } }
  const __attribute__((address_space(3))) float* bt=(const __attribute__((address_space(3))) float*)(shm3+LDS_DK)+g*128;
  float mx=sink2;
  #pragma unroll
  for(int j=0;j<3;++j){
    #pragma unroll
    for(int r=0;r<16;++r){
      const int kv=64*(t_lo+j)+crow(r,hi); const int d0_=qpos-kv, d1_=d0_-32;
      const bool ok0=(j<ntile)&&(d0_>=0)&&(d0_<128), ok1=(j<ntile)&&(d1_>=0)&&(d1_<128);
      const float s0=ok0?S0[j][r]+bt[d0_&127]:-INFINITY, s1=ok1?S1[j][r]+bt[d1_&127]:-INFINITY;
      S0[j][r]=s0; S1[j][r]=s1; mx=fmaxf(mx,fmaxf(s0,s1)); } }
  mx=fmaxf(mx,bperm_f(lane^32,mx));
  float l=0.f;
  #pragma unroll
  for(int j=0;j<3;++j){
    #pragma unroll
    for(int r=0;r<16;++r){ const float p0=__builtin_amdgcn_exp2f(S0[j][r]-mx), p1=__builtin_amdgcn_exp2f(S1[j][r]-mx); S0[j][r]=p0; S1[j][r]=p1; l+=p0+p1; } }
  l+=bperm_f(lane^32,l); l+=__builtin_amdgcn_exp2f(sink2-mx);
  f32x16 o[2]; o[0]=f32x16{}; o[1]=f32x16{};
  const int vb0=(int)(lds0+LDS_V)+((lane>>4)&1)*32+(lane&3)*8+(4*hi+((lane&15)>>2))*64;
  #define PKW(P,B) cvtpk_s(P[B],P[B+1])
  #pragma unroll
  for(int j=0;j<3;++j) if(j<ntile){
    u32x4 pw0=(u32x4){PKW(S0[j],0),PKW(S0[j],2),PKW(S0[j],4),PKW(S0[j],6)},pw1=(u32x4){PKW(S0[j],8),PKW(S0[j],10),PKW(S0[j],12),PKW(S0[j],14)};
    u32x4 pw2=(u32x4){PKW(S1[j],0),PKW(S1[j],2),PKW(S1[j],4),PKW(S1[j],6)},pw3=(u32x4){PKW(S1[j],8),PKW(S1[j],10),PKW(S1[j],12),PKW(S1[j],14)};
    pv(o,vb0+j*SLOTB,__builtin_bit_cast(bf16x8,pw0),__builtin_bit_cast(bf16x8,pw1),__builtin_bit_cast(bf16x8,pw2),__builtin_bit_cast(bf16x8,pw3)); }
  #undef PKW
  if(hi==0)wsf[32+r32]=l; asm volatile("s_waitcnt lgkmcnt(0)":::"memory");
  float rli[16];
  #pragma unroll
  for(int r=0;r<16;++r)rli[r]=__builtin_amdgcn_rcpf(wsf[32+crow(r,hi)]);
  bf16*Ow=OC+(rowbase+64*a+32*half)*PO+hq*64;
  { bf16*stg=(bf16*)(shm+LDS_OST)+wid*2048;
    #pragma unroll
    for(int r=0;r<16;++r){const int orow=crow(r,hi);
      #pragma unroll
      for(int d0=0;d0<2;++d0)stg[orow*64+d0*32+r32]=__float2bfloat16(o[d0][r]*rli[r]);}
    asm volatile("s_waitcnt lgkmcnt(0)":::"memory");
    #pragma unroll
    for(int i=0;i<4;++i){const int row=i*8+(lane>>3),ch=lane&7; const u32x4 v=*(const u32x4*)(stg+row*64+ch*8); if(64*a+32*half+row<TTOK)*(u32x4*)(Ow+(long)row*PO+ch*8)=v;} }
  asm volatile("s_waitcnt lgkmcnt(0)\n\ts_barrier":::"memory");
}
#undef SBAR
#undef WAIT_BAR
}

#define GAS __attribute__((address_space(1)))
#define LAS __attribute__((address_space(3)))
typedef unsigned short bf16;
typedef unsigned v4u __attribute__((ext_vector_type(4)));
typedef float f32x4 __attribute__((ext_vector_type(4)));
typedef short bf16x8 __attribute__((ext_vector_type(8)));
typedef GAS unsigned gu32;
typedef GAS unsigned long long gu64;
#define RLX_AGENT __ATOMIC_RELAXED, __HIP_MEMORY_SCOPE_AGENT
#define LDS_WAIT() asm volatile("s_waitcnt lgkmcnt(0)" ::: "memory")
#define VM_WAIT() asm volatile("s_waitcnt vmcnt(0)" ::: "memory")
__device__ __forceinline__ unsigned long long rt() { return __builtin_amdgcn_s_memrealtime(); }
__device__ __forceinline__ unsigned f2bf(float f) { unsigned u = __builtin_bit_cast(unsigned, f); return (u + 0x7fffu + ((u >> 16) & 1u)) >> 16; }
__device__ __forceinline__ unsigned pk2(float lo, float hi) { return f2bf(lo) | (f2bf(hi) << 16); }

#define XB_TMO      128
#define XB_XCNT(j)  (256  + 64 * (j))
#define XB_XSUB(j)  (1280 + 64 * (j))
#define XB_XGEN(j)  (2304 + 64 * (j))
#define XB_TOP      3328
#define XB_TOPGEN   3392
#define XCD_BAR_WORDS 3456
#define XB_SPIN_CAP (1u << 18)

__device__ __forceinline__ unsigned xb_ld(unsigned* p)              { return __hip_atomic_load(p, __ATOMIC_RELAXED, __HIP_MEMORY_SCOPE_AGENT); }
__device__ __forceinline__ unsigned xb_add(unsigned* p, unsigned v) { return __hip_atomic_fetch_add(p, v, __ATOMIC_RELAXED, __HIP_MEMORY_SCOPE_AGENT); }
__device__ __forceinline__ unsigned xb_xcc_id() { return (unsigned)__builtin_amdgcn_s_getreg((3 << 11) | 20) & 0xFu; }
#define XB_SPIN(cond, bar) do { unsigned _sp = 0; while (cond) { __builtin_amdgcn_s_sleep(1); \
    if ((++_sp & 255u) == 0u) { if (xb_ld(&(bar)[XB_TMO])) break; if (_sp > XB_SPIN_CAP) { atomicAdd(&(bar)[XB_TMO], 1u); break; } } } } while (0)

struct XcdBarrier {
    unsigned* bar; unsigned x;
    volatile LAS unsigned* st;
};

__device__ __forceinline__ XcdBarrier xcd_barrier_post(unsigned* bar, volatile LAS unsigned* st) {
    XcdBarrier b; b.bar = bar; b.x = xb_xcc_id(); b.st = st;
    if (threadIdx.x == 0) (void)xb_add(&bar[XB_XCNT(b.x)], 1u);
    return b;
}
__device__ __forceinline__ void xcd_barrier_complete(unsigned* bar, unsigned x, unsigned& nloc, unsigned& nx) {
    const unsigned G = gridDim.x * gridDim.y * gridDim.z;
    unsigned sum, cnt, mine, sp = 0u;
    for (;;) {
        sum = 0u; cnt = 0u; mine = 0u;
#pragma unroll
        for (unsigned j = 0; j < 16; ++j) { const unsigned c = xb_ld(&bar[XB_XCNT(j)]); sum += c; cnt += (c > 0u) ? 1u : 0u; mine = (j == x) ? c : mine; }
        if (sum == G) break;
        __builtin_amdgcn_s_sleep(1);
        if ((++sp & 255u) == 0u) { if (xb_ld(&bar[XB_TMO])) break; if (sp > XB_SPIN_CAP) { atomicAdd(&bar[XB_TMO], 1u); break; } }
    }
    nloc = mine > 0u ? mine : 1u; nx = cnt > 0u ? cnt : 1u;
}

__device__ __forceinline__ void xcd_barrier(const XcdBarrier& b) {
    asm volatile("s_waitcnt vmcnt(0)" ::: "memory");
    __syncthreads();
    if (threadIdx.x == 0) {
        unsigned* bar = b.bar;
        __builtin_amdgcn_s_waitcnt(0);
        unsigned nloc = b.st[0], nx = b.st[1];
        if (nloc == 0u) { xcd_barrier_complete(bar, b.x, nloc, nx); b.st[0] = nloc; b.st[1] = nx; }
        const unsigned old = xb_add(&bar[XB_XSUB(b.x)], 1u);
        const unsigned gen = old / nloc;
        if (old + 1u == (gen + 1u) * nloc) {
            __builtin_amdgcn_fence(__ATOMIC_RELEASE, "agent");
            asm volatile("s_waitcnt vmcnt(0)" ::: "memory");
            const unsigned og = xb_add(&bar[XB_TOP], 1u);
            const unsigned tg = og / nx;
            if (og + 1u == (tg + 1u) * nx) xb_add(&bar[XB_TOPGEN], 1u);
            else XB_SPIN(xb_ld(&bar[XB_TOPGEN]) == tg, bar);
            __builtin_amdgcn_fence(__ATOMIC_ACQUIRE, "agent");
            xb_add(&bar[XB_XGEN(b.x)], 1u);
            asm volatile("s_waitcnt vmcnt(0)" ::: "memory");
        } else {
            XB_SPIN(xb_ld(&bar[XB_XGEN(b.x)]) == gen, bar);
            __builtin_amdgcn_fence(__ATOMIC_ACQUIRE, "agent");
            asm volatile("s_waitcnt vmcnt(0)" ::: "memory");
        }
    }
    __syncthreads();
}

constexpr int NWAVES = 8;
constexpr int T_TOK = 4112, M_TOK = 32896, DMODEL = 1024, NPROJ = 6656, DFF = 2816, MP = 33280;
constexpr int HALF_ROWS = 4 * T_TOK  , NT_HALF = 65, MLOC = 16896  ;
constexpr int QA_OFF = 0, KA_OFF = 512, VA_OFF = 640, QF_OFF = 768, KF_OFF = 1280, VF_OFF = 1792, XC_OFF = 2304, YC_OFF = 2816, GATE_OFF = 3328, FL_OFF = 6400;
constexpr int LRU_CH = 129;
constexpr float C2 = 0.125f * 1.4426950408889634f, LOG2E = 1.4426950408889634f;
constexpr size_t MiB = 1u << 20;
constexpr size_t WS_CTL = 0, CTL_ZERO_BYTES = 64 * 1024;
constexpr size_t WS_SSQA = 1 * MiB, WS_SSQB = WS_SSQA + 512 * 1024, WS_HMETA = 2 * MiB  , WS_FL = 3 * MiB  , WS_DK = 4 * MiB  ;
constexpr size_t WS_LRUP = 5 * MiB  , WS_LRUH = 7 * MiB;
constexpr size_t WS_WIN = 9 * MiB;
constexpr size_t WS_WB = WS_WIN + 13 * MiB;
constexpr size_t WS_WOUT = WS_WB + 3 * MiB;
constexpr size_t WS_WFFI = WS_WOUT + 2 * MiB;
constexpr size_t WS_WFFO = WS_WFFI + 11 * MiB;
constexpr size_t WS_WR = WS_WFFO + 6 * MiB, WS_WI = WS_WR + 65536;
constexpr size_t WS_PART = 44 * MiB + 256 * 1024;
constexpr size_t WS_HB = 46 * MiB;
constexpr size_t WS_MG = WS_HB + 65 * MiB;
constexpr size_t WS_OC = WS_MG + 65 * MiB;
constexpr size_t WS_PROJ = WS_OC + 50 * MiB;
constexpr size_t WS_W2ND = WS_PROJ + 215 * MiB;
constexpr size_t WS_WSET = WS_W2ND - WS_WIN;
constexpr size_t WS_PARTK = WS_W2ND + 37 * MiB;
constexpr size_t WS_END = WS_PARTK + 6 * MiB;
static_assert(WS_WI + 65536 <= WS_HB && (size_t)MP * 1024 * 2 <= 65 * MiB && (size_t)MLOC * 1536 * 2 <= 50 * MiB && (size_t)MLOC * NPROJ * 2 <= 215 * MiB && (size_t)MP * DFF * 2 <= 215 * MiB && WS_END <= 512 * MiB, "ws map");
constexpr int CW_TICK = 8192;
constexpr int CW_BAR = 4096;
constexpr int RING_BYTES = 131072, MISC_OFF = RING_BYTES + 320, LDS_BYTES = 147456;

using pg8::sigmoid_f;
struct Args { const float* in[20]; float* out; unsigned char* ws; int ph_lo, ph_hi; };
struct Frame {
    LAS unsigned char* lds; int tid, lane, wave, G, bid;
    float* out; unsigned char* ws;
};
__device__ __forceinline__ float wave_sum(float v, int lane) {
#pragma unroll
    for (int o = 1; o < 64; o <<= 1) v += bperm_f(lane ^ o, v);
    return v;
}
__device__ __forceinline__ float* hrow(const Frame& F, int m) { const int b = m / T_TOK, t = m - b * T_TOK; return (t < 16) ? (float*)(F.ws + WS_HMETA) + (size_t)(b * 16 + t) * DMODEL : F.out + ((size_t)b * 4096 + (t - 16)) * DMODEL; }

__device__ __forceinline__ void wt_item(const float* __restrict__ W, int ldn, int s0, int nv, int K, bf16* WT, int n0, const float* __restrict__ kscale, float cs, LAS float* scr, int kb, int lane) {
    const int k0 = 64 * kb;
    { const int c4 = (lane & 7) * 4, r0 = lane >> 3;
        f32x4 v[8]; float ks[8];
#pragma unroll
        for (int i = 0; i < 8; ++i) { const int kk = r0 + 8 * i; ks[i] = kscale ? kscale[k0 + kk] : 1.f;
            v[i] = *(const f32x4*)(W + (size_t)(k0 + kk) * ldn + s0 + (c4 < nv ? c4 : 0)); }
#pragma unroll
        for (int i = 0; i < 8; ++i) { const int kk = r0 + 8 * i; const float m_ = (c4 < nv) ? ks[i] * cs : 0.f;
            scr[kk * 33 + c4 + 0] = v[i][0] * m_; scr[kk * 33 + c4 + 1] = v[i][1] * m_; scr[kk * 33 + c4 + 2] = v[i][2] * m_; scr[kk * 33 + c4 + 3] = v[i][3] * m_; } }
    LDS_WAIT(); asm volatile("" ::: "memory");
    const int c = lane & 7;
#pragma unroll
    for (int j = 0; j < 4; ++j) { const int n = (lane >> 3) + 8 * j; const LAS float* s = scr + (8 * c) * 33 + n;
        v4u o; o.x = pk2(s[0 * 33], s[1 * 33]); o.y = pk2(s[2 * 33], s[3 * 33]); o.z = pk2(s[4 * 33], s[5 * 33]); o.w = pk2(s[6 * 33], s[7 * 33]);
        *(GAS v4u*)(WT + (size_t)(n0 + n) * K + k0 + 8 * c) = o; }
    LDS_WAIT(); asm volatile("" ::: "memory");
}
__device__ __forceinline__ void wconv_phase(Frame& F, int l, int skip, const float* norm_mix, const float* w_in, const float* lru_wr, const float* lru_wi, const float* w_branch, const float* w_out, const float* norm_ffn, const float* w_ffi, const float* w_ffo) {
    LAS float* scr = (LAS float*)(F.lds + F.wave * 16384);
    if (F.bid < skip) return;
    const int gw = (F.bid - skip) * NWAVES + F.wave, NGW = (F.G - skip) * NWAVES; const size_t wo = (l & 1) ? WS_WSET : 0;
    constexpr int I_IN = 16 * 208, I_FFI = 16 * 176, I_WB = 3 * 8 * 32, I_OUT = 16 * 32, I_FFO = 44 * 32, I_LRU = 2 * 8 * 2;
    constexpr int NITEMS = I_IN + I_FFI + I_WB + I_OUT + I_FFO + I_LRU;
    bf16* Win_t = (bf16*)(F.ws + wo + WS_WIN); bf16* Wb_t = (bf16*)(F.ws + wo + WS_WB); bf16* Wout_t = (bf16*)(F.ws + wo + WS_WOUT); bf16* Wffi_t = (bf16*)(F.ws + wo + WS_WFFI); bf16* Wffo_t = (bf16*)(F.ws + wo + WS_WFFO);
    for (int it = gw; it < NITEMS; it += NGW) {
        int r = it;
        if (r < I_IN) { const int kb = r / 208, nb = r % 208, n0 = 32 * nb; int s0, nv = 32; float cs = 1.f;
            if (n0 < 2304) { s0 = n0; if (n0 < 512 || (n0 >= 768 && n0 < 1280)) cs = C2; } else if (n0 < 6400) s0 = n0 + 8; else if (n0 == 6400) { s0 = 2304; nv = 8; } else { s0 = 0; nv = 0; }
            wt_item(w_in + (size_t)l * 1024 * 6408, 6408, s0, nv, 1024, Win_t, n0, norm_mix + l * 1024, cs, scr, kb, F.lane); continue; } r -= I_IN;
        if (r < I_FFI) { const int kb = r / 176, nb = r % 176, n0 = 32 * nb, pn = n0 >> 8, w = n0 & 255; const int s0 = (w < 128) ? 128 * pn + w : 2816 + 128 * pn + (w - 128);
            wt_item(w_ffi + (size_t)l * 1024 * 5632, 5632, s0, 32, 1024, Wffi_t, n0, norm_ffn + l * 1024, 1.f, scr, kb, F.lane); continue; } r -= I_FFI;
        if (r < I_WB) { const int g = r / 256, q = r % 256, kb = q / 32, nb = q % 32;
            wt_item(w_branch + (size_t)(l * 3 + g) * 512 * 1024, 1024, 32 * nb, 32, 512, Wb_t, g * 1024 + 32 * nb, nullptr, 1.f, scr, kb, F.lane); continue; } r -= I_WB;
        if (r < I_OUT) { const int kb = r / 32, nb = r % 32;
            wt_item(w_out + (size_t)l * 1024 * 1024, 1024, 32 * nb, 32, 1024, Wout_t, 32 * nb, nullptr, 1.f, scr, kb, F.lane); continue; } r -= I_OUT;
        if (r < I_FFO) { const int kb = r / 32, nb = r % 32;
            wt_item(w_ffo + (size_t)l * 2816 * 1024, 1024, 32 * nb, 32, 2816, Wffo_t, 32 * nb, nullptr, 1.f, scr, kb, F.lane); continue; } r -= I_FFO;
        { const int mat = r / 16, q = r % 16, h = q / 2, nb = q % 2;
            wt_item((mat ? lru_wi : lru_wr) + (size_t)(l * 8 + h) * 4096, 64, 32 * nb, 32, 64, (bf16*)(F.ws + wo + (mat ? WS_WI : WS_WR)) + h * 4096, 32 * nb, nullptr, 1.f, scr, 0, F.lane); }
    }
}
__device__ __forceinline__ void init_phase(Frame& F, const float* x, const float* meta) {
    const int gw = F.bid * NWAVES + F.wave, NGW = F.G * NWAVES;
    bf16* hb = (bf16*)(F.ws + WS_HB); unsigned long long* ssqA = (unsigned long long*)(F.ws + WS_SSQA); unsigned long long* ssqB = (unsigned long long*)(F.ws + WS_SSQB);
    for (int m = gw; m < MP; m += NGW) {
        GAS unsigned long long* o8 = (GAS unsigned long long*)(hb + (size_t)m * DMODEL) + F.lane;
        if (m < M_TOK) { const int b = m / T_TOK, t = m - b * T_TOK;
            const float* src = (t < 16) ? meta + (size_t)t * DMODEL : x + ((size_t)b * 4096 + (t - 16)) * DMODEL;
            const GAS f32x4* xr = (const GAS f32x4*)src + F.lane; GAS f32x4* hr = (GAS f32x4*)hrow(F, m) + F.lane;
            float s = 0.f;
#pragma unroll
            for (int j = 0; j < 4; ++j) { const f32x4 v = xr[64 * j]; hr[64 * j] = v; s += (v.x * v.x + v.y * v.y) + (v.z * v.z + v.w * v.w);
                o8[64 * j] = (unsigned long long)pk2(v.x, v.y) | ((unsigned long long)pk2(v.z, v.w) << 32); }
            s = wave_sum(s, F.lane); if (F.lane == 0) { unsigned long long z = 0ull; asm volatile("" : "+v"(z)); ssqB[m] = (unsigned long long)(s * 1048576.0f); ssqA[m] = z; }
        } else {
            unsigned long long z = 0ull; asm volatile("" : "+v"(z));
#pragma unroll
            for (int j = 0; j < 4; ++j) o8[64 * j] = z;
            if (F.lane == 0) { ssqB[m] = z; ssqA[m] = z; }
        }
    }
}
__device__ __forceinline__ void final_phase(Frame& F, const float* norm_final) {
    const int gw = F.bid * NWAVES + F.wave, NGW = F.G * NWAVES; const unsigned long long* ssqB = (const unsigned long long*)(F.ws + WS_SSQB);
    for (int r = gw; r < 32768; r += NGW) { const int b = r >> 12, tt = r & 4095, m = b * T_TOK + 16 + tt;
        const float s = rsqrtf((float)ssqB[m] * (1.0f / (1024.0f * 1048576.0f)) + 1e-6f);
        GAS f32x4* hr = (GAS f32x4*)(F.out + (size_t)r * DMODEL) + F.lane; const GAS f32x4* gr = (const GAS f32x4*)norm_final + F.lane;
#pragma unroll
        for (int j = 0; j < 4; ++j) { f32x4 v = hr[64 * j]; const f32x4 g = gr[64 * j]; v = v * s * g; hr[64 * j] = v; } }
}
__device__ __forceinline__ void zero_u64(Frame& F, unsigned long long* p, int n) { unsigned long long z = 0ull; asm volatile("" : "+v"(z)); for (int i = F.bid * NWAVES * 64 + F.tid; i < n; i += F.G * NWAVES * 64) p[i] = z; }

__device__ __forceinline__ void fixup_phase(Frame& F) {
    if (F.bid >= 2) return;
    const int half = F.bid; const bf16* part = (const bf16*)(F.ws + WS_PART) + (size_t)half * 3 * 64 * 1024; bf16* mg = (bf16*)(F.ws + WS_MG) + (size_t)(half * HALF_ROWS + 16384) * DMODEL;
    for (int i = F.tid; i < 64 * 128; i += NWAVES * 64) { const v4u a = *(const v4u*)(part + (size_t)i * 8), b = *(const v4u*)(part + 65536 + (size_t)i * 8), c = *(const v4u*)(part + 131072 + (size_t)i * 8);
        v4u o;
#define FX_(f) o.f = pk2(__uint_as_float(a.f << 16) + __uint_as_float(b.f << 16) + __uint_as_float(c.f << 16), __uint_as_float(a.f & 0xffff0000u) + __uint_as_float(b.f & 0xffff0000u) + __uint_as_float(c.f & 0xffff0000u))
        FX_(x); FX_(y); FX_(z); FX_(w);
#undef FX_
        *(v4u*)(mg + (size_t)i * 8) = o; }
}
__device__ __forceinline__ void fixk_phase(Frame& F, int npieces, unsigned long long* ssq) {
    if (F.bid >= 128) return;
    const int grow = 32768 + F.bid, c = 2 * F.tid; typedef float f32x2v __attribute__((ext_vector_type(2)));
    const float* pk = (const float*)(F.ws + WS_PARTK) + (size_t)F.bid * DMODEL + c; float* hp = hrow(F, grow) + c;
    f32x2v a = *(const f32x2v*)hp;
    for (int p = 0; p < npieces; ++p) a += *(const f32x2v*)(pk + (size_t)p * 128 * DMODEL);
    *(f32x2v*)hp = a; *(unsigned*)((bf16*)(F.ws + WS_HB) + (size_t)grow * DMODEL + c) = pk2(a.x, a.y);
    const float s = wave_sum(a.x * a.x + a.y * a.y, F.lane);
    if (F.lane == 0) atomicAdd(ssq + grow, (unsigned long long)(s * 1048576.0f));
}
__device__ __forceinline__ float logsig_f(float x) { return fminf(x, 0.f) - __logf(1.f + __expf(-fabsf(x))); }
__device__ __forceinline__ float one_minus_exp(float x) { const float s = -x * (1.f + x * (0.5f + x * 0.16666667f)); const float e = 1.f - __expf(x); return (x > -1e-3f) ? s : e; }
__device__ __forceinline__ void cumsum_unit(Frame& F, int l, int lb, const float* fbias) {
    const int h = F.wave, lane = F.lane; const float* fl = (const float*)(F.ws + WS_FL); float* dk = (float*)(F.ws + WS_DK) + (size_t)(lb * 8 + h) * 4352;
    const float fb = fbias[l * 8 + h]; float carry = 0.f;
    for (int cq = 0; cq < 17; ++cq) { const int t0 = 256 * cq + 4 * lane; float v[4];
#pragma unroll
        for (int j = 0; j < 4; ++j) { const int t = t0 + j; const float x = fl[(size_t)(lb * T_TOK + (t < T_TOK ? t : T_TOK - 1)) * 8 + h]; const float lv = logsig_f(x + fb); v[j] = (t < T_TOK) ? lv : 0.f; }
        v[1] += v[0]; v[2] += v[1]; v[3] += v[2];
        float inc = v[3];
#pragma unroll
        for (int o = 1; o < 64; o <<= 1) { const float u = bperm_f(lane - o, inc); if (lane >= o) inc += u; }
        const float ex = carry + inc - v[3];
        f32x4 o4 = { -(ex + v[0]) * LOG2E, -(ex + v[1]) * LOG2E, -(ex + v[2]) * LOG2E, -(ex + v[3]) * LOG2E };
        *(f32x4*)(dk + t0) = o4;
        carry += bperm_f(63, inc);
    }
}
__device__ __forceinline__ float bf2f(unsigned short u) { return __uint_as_float((unsigned)u << 16); }
__device__ __forceinline__ int crow_(int r, int hi) { return (r & 3) + 8 * (r >> 2) + 4 * hi; }
template <int MODE> __device__ __forceinline__ void lru_unit(Frame& F, int l, int lb, int ch, const float* conv_w, const float* conv_b, const float* lru_br, const float* lru_bi, const float* lam) {
    typedef float f32x16 __attribute__((ext_vector_type(16)));
    const int tid = F.tid, wid = F.wave, lane = F.lane, c = tid, r32 = lane & 31, hi = lane >> 5;
    const bf16* proj = (const bf16*)(F.ws + WS_PROJ);
    const int t0 = ch * 32, nt = (T_TOK - t0) < 32 ? (T_TOK - t0) : 32;
    LAS unsigned short* XCb = (LAS unsigned short*)(F.lds);
    LAS float* MU = (LAS float*)(F.lds);
    LAS float* AS = (LAS float*)(F.lds + 65536);
    LAS unsigned short* XR = (LAS unsigned short*)(F.lds + 65536);
    const unsigned lds0 = (unsigned)(uintptr_t)(unsigned char*)F.lds;
    { const bf16* rowp = proj + (size_t)(lb * T_TOK) * NPROJ + XC_OFF + lane * 8;
#pragma unroll
        for (int i = 0; i < 5; ++i) { const int row = wid + 8 * i; if (row < 35) { int tt = t0 - 3 + row; tt = tt < 0 ? 0 : tt;
            attn_body::glds16(rowp + (size_t)tt * NPROJ, (unsigned)__builtin_amdgcn_readfirstlane(lds0 + 65536 + row * 1024)); } }
    }
    bf16x8 wbr[2][4], wbi[2][4];
    { const size_t wo = (l & 1) ? WS_WSET : 0; const bf16* Wr = (const bf16*)(F.ws + wo + WS_WR) + wid * 4096; const bf16* Wi = (const bf16*)(F.ws + wo + WS_WI) + wid * 4096;
#pragma unroll
        for (int jt = 0; jt < 2; ++jt)
#pragma unroll
            for (int ks = 0; ks < 4; ++ks) { wbr[jt][ks] = *(const bf16x8*)(Wr + (jt * 32 + r32) * 64 + 16 * ks + 8 * hi); wbi[jt][ks] = *(const bf16x8*)(Wi + (jt * 32 + r32) * 64 + 16 * ks + 8 * hi); } }
    const float w0 = conv_w[(l * 4 + 0) * 512 + c], w1 = conv_w[(l * 4 + 1) * 512 + c], w2 = conv_w[(l * 4 + 2) * 512 + c], w3 = conv_w[(l * 4 + 3) * 512 + c], cb = conv_b[l * 512 + c];
    asm volatile("s_waitcnt vmcnt(0)" ::: "memory"); __syncthreads();
    float xcv[32];
    { const float m3 = (t0 >= 3) ? 1.f : 0.f;
        float xm3 = bf2f(XR[0 * 512 + c]) * m3, xm2 = bf2f(XR[1 * 512 + c]) * m3, xm1 = bf2f(XR[2 * 512 + c]) * m3;
#pragma unroll
        for (int t = 0; t < 32; ++t) { const float x0 = bf2f(XR[(t + 3) * 512 + c]);
            xcv[t] = w0 * xm3 + w1 * xm2 + w2 * xm1 + w3 * x0 + cb; xm3 = xm2; xm2 = xm1; xm1 = x0;
            XCb[t * 520 + c] = (unsigned short)f2bf(xcv[t]); } }
    __syncthreads();
    bf16x8 af[4];
#pragma unroll
    for (int ks = 0; ks < 4; ++ks) af[ks] = *(const LAS bf16x8*)(XCb + r32 * 520 + 64 * wid + 16 * ks + 8 * hi);
    __syncthreads();
    f32x16 dr[2], di[2];
    {
#pragma unroll
        for (int jt = 0; jt < 2; ++jt) { dr[jt] = f32x16{}; di[jt] = f32x16{};
#pragma unroll
            for (int ks = 0; ks < 4; ++ks) { dr[jt] = __builtin_amdgcn_mfma_f32_32x32x16_bf16(af[ks], wbr[jt][ks], dr[jt], 0, 0, 0); di[jt] = __builtin_amdgcn_mfma_f32_32x32x16_bf16(af[ks], wbi[jt][ks], di[jt], 0, 0, 0); } } }
#pragma unroll
    for (int jt = 0; jt < 2; ++jt) { const int cc = 64 * wid + 32 * jt + r32; const float brv = lru_br[l * 512 + cc], biv = lru_bi[l * 512 + cc], lsl = 8.0f * logsig_f(lam[l * 512 + cc]);
#pragma unroll
        for (int r = 0; r < 16; ++r) { const int t = crow_(r, hi); const float rr = sigmoid_f(dr[jt][r] + brv), gi = sigmoid_f(di[jt][r] + biv), la = rr * lsl;
            AS[t * 512 + cc] = __expf(la); MU[t * 512 + cc] = __builtin_amdgcn_sqrtf(one_minus_exp(2.0f * la)) * gi; } }
    __syncthreads();
    float* lp = (float*)(F.ws + WS_LRUP) + (size_t)(lb * LRU_CH) * 512 + c; float* lh = (float*)(F.ws + WS_LRUH) + (size_t)(lb * LRU_CH) * 512 + c;
    float h = 0.f, pa = 1.f;
    if (MODE == 1) {
        for (int k0 = 0; k0 < ch; k0 += 16) { float pv_[16], hv_[16];
#pragma unroll
            for (int j = 0; j < 16; ++j) { const int k = (k0 + j < ch) ? k0 + j : ch - 1; pv_[j] = lp[(size_t)k * 512]; hv_[j] = lh[(size_t)k * 512]; }
#pragma unroll
            for (int j = 0; j < 16; j += 4) asm volatile("" :: "v"(pv_[j]), "v"(pv_[j + 1]), "v"(pv_[j + 2]), "v"(pv_[j + 3]), "v"(hv_[j]), "v"(hv_[j + 1]), "v"(hv_[j + 2]), "v"(hv_[j + 3]));
#pragma unroll
            for (int j = 0; j < 16; ++j) { const bool ok = k0 + j < ch; const float hn = pv_[j] * h + hv_[j]; h = ok ? hn : h; } }
    }
#pragma unroll
    for (int t = 0; t < 32; ++t) { const float a = AS[t * 512 + c]; const float hn = a * h + MU[t * 512 + c] * xcv[t]; const bool ok = t < nt; h = ok ? hn : h; pa = ok ? pa * a : pa; if (MODE == 1) MU[t * 512 + c] = hn; }
    if (MODE == 0) { lp[(size_t)ch * 512] = pa; lh[(size_t)ch * 512] = h; }
    __syncthreads();
    if (MODE == 1) {
        { const bf16* rowp = proj + (size_t)(lb * T_TOK + t0) * NPROJ + YC_OFF + lane * 8;
#pragma unroll
            for (int i = 0; i < 4; ++i) { const int row = wid + 8 * i; attn_body::glds16(rowp + (size_t)row * NPROJ, (unsigned)__builtin_amdgcn_readfirstlane(lds0 + 65536 + row * 1024)); } }
        asm volatile("s_waitcnt vmcnt(0)" ::: "memory"); __syncthreads();
        bf16* op = (bf16*)(F.ws + WS_OC) + (size_t)(lb * T_TOK + t0 + wid) * 1536 + 1024 + lane * 8;
        unsigned yo = 65536 + wid * 1024 + lane * 16, ho = wid * 2048 + lane * 32; int row = wid;
#pragma unroll 1
        for (int pss = 0; pss < 4; ++pss, op += 8 * 1536, yo += 8192, ho += 16384, row += 8) {
            const v4u yw = *(const LAS v4u*)(F.lds + yo);
            const f32x4 h0 = *(const LAS f32x4*)(F.lds + ho), h1 = *(const LAS f32x4*)(F.lds + ho + 16);
            float y[8] = { __uint_as_float(yw.x << 16), __uint_as_float(yw.x & 0xffff0000u), __uint_as_float(yw.y << 16), __uint_as_float(yw.y & 0xffff0000u),
                           __uint_as_float(yw.z << 16), __uint_as_float(yw.z & 0xffff0000u), __uint_as_float(yw.w << 16), __uint_as_float(yw.w & 0xffff0000u) };
            float o[8];
#pragma unroll
            for (int j = 0; j < 8; ++j) { const float u = 0.7978845608028654f * (y[j] + 0.044715f * y[j] * y[j] * y[j]);
                const float th = 1.f - 2.f * __builtin_amdgcn_rcpf(1.f + __expf(2.f * u)); o[j] = 0.5f * y[j] * (1.f + th) * (j < 4 ? h0[j & 3] : h1[j & 3]); }
            v4u ow; ow.x = pk2(o[0], o[1]); ow.y = pk2(o[2], o[3]); ow.z = pk2(o[4], o[5]); ow.w = pk2(o[6], o[7]);
            if (row < nt) *(v4u*)op = ow; }
        __syncthreads();
    }
}

#ifndef ONE_LAUNCH
#define ONE_LAUNCH 1
#endif
#define INP(k) karg_ptr(8 * (k))
#ifndef DUP
#define DUP -1
#endif
__device__ __forceinline__ int nrep_of(int code) { int n = (DUP == code) ? 2 : 1; if (DUP == code) asm volatile("" : "+s"(n)); return n; }
#define NREP(code) for (int rep_ = 0, nr_ = nrep_of(code); rep_ < nr_; ++rep_)
enum { ST_INIT = 0, ST_WCONV, ST_G1, ST_S1, ST_S2, ST_S3, ST_G4, ST_G5, ST_G6, ST_FINAL, ST_FIX, ST_FIXK4, ST_FIXK6 };
__device__ __forceinline__ void make_frame(Frame& F, unsigned char* lds, int wv) {
    unsigned lb_ = (unsigned)(uintptr_t)(LAS unsigned char*)lds; asm volatile("" : "+s"(lb_));
    int g_ = gridDim.x, b_ = blockIdx.x; asm volatile("" : "+s"(g_), "+s"(b_));
    F.lds = (LAS unsigned char*)(uintptr_t)lb_; F.tid = otid(wv); F.lane = F.tid & 63; F.wave = __builtin_amdgcn_readfirstlane(F.tid >> 6); F.G = g_; F.bid = b_;
    F.out = (float*)karg_ptr(160); F.ws = (unsigned char*)karg_ptr(168);
}
template <int ST> __device__ __forceinline__ void run_stage(unsigned char* lds, int l, int half, int wv, int rep = 1) {
    Frame F; make_frame(F, lds, wv);
    unsigned char* ws = F.ws;
    bf16* hb = (bf16*)(ws + WS_HB); bf16* mg = (bf16*)(ws + WS_MG); bf16* oc = (bf16*)(ws + WS_OC); bf16* proj = (bf16*)(ws + WS_PROJ);
    unsigned long long* ssqA = (unsigned long long*)(ws + WS_SSQA); unsigned long long* ssqB = (unsigned long long*)(ws + WS_SSQB);
    const int grow0 = half * HALF_ROWS; const size_t wo = (l & 1) ? WS_WSET : 0;
    if constexpr (ST == ST_INIT) { init_phase(F, INP(0), INP(1)); }
    if constexpr (ST == ST_INIT || ST == ST_WCONV) { wconv_phase(F, l, 0, INP(3), INP(4), INP(9), INP(11), INP(14), INP(15), INP(16), INP(17), INP(18)); }
    if constexpr (ST == ST_FINAL) { final_phase(F, INP(19)); }
    if constexpr (ST == ST_FIX) { fixup_phase(F); }
    if constexpr (ST == ST_FIXK4) { fixk_phase(F, 4, ssqA); }
    if constexpr (ST == ST_FIXK6) { fixk_phase(F, 11, ssqB); }
    if constexpr (ST == ST_G1) {
                    pg8::Gemm g{(const pg8::bf16_t*)(hb + (size_t)grow0 * DMODEL), (const pg8::bf16_t*)(ws + wo + WS_WIN)};
                    typedef pg8::Order<NT_HALF, 26, 1> Ord; Ord S; S.init(F.G, F.bid);
                    pg8::EpiProj E{(pg8::bf16_t*)proj, (float*)(ws + WS_FL), ssqB, grow0};

pg8::gemm_phase<pg8::EpiProj, Ord, true, true, 1024, 1024, 0, 0>(F.lds, g, S, E, wv);
    }
    if constexpr (ST == ST_S1) {
        constexpr int N_SWA = 4 * 2 * 65, N_LRU = 4 * LRU_CH, N_CS = 4;
        NREP(32) for (int u = F.bid - 128; u >= 0 && u < N_CS; u += F.G) cumsum_unit(F, l, u, INP(6));
        NREP(30) for (int u = F.bid; u < N_SWA; u += F.G) { const int lb = u / 130, w = u % 130;
            attn_body::swa_unit(lb, w / 65, w % 65, (const attn_body::bf16*)proj, (attn_body::bf16*)oc, INP(2), INP(5) + l * 8, (char*)lds, wv); }
        NREP(31) for (int u = F.G - 1 - F.bid; u < N_LRU; u += F.G) lru_unit<0>(F, l, u / LRU_CH, u % LRU_CH, INP(7), INP(8), INP(10), INP(12), INP(13));
    }
    if constexpr (ST == ST_S2) {
        constexpr int N_LRU = 4 * LRU_CH, N_FOX = 4 * 8 * 17, N_ALL = N_LRU + N_FOX;
        unsigned* tick = (unsigned*)(ws + WS_CTL) + CW_TICK + 64 * ((l * 2 + half) * 2 + (rep & 1));
        volatile LAS unsigned* tl = (volatile LAS unsigned*)(F.lds + MISC_OFF) + 16;
#define NEXT_TICKET(t_) do { if (F.tid == 0) *tl = __hip_atomic_fetch_add(tick, 1u, __ATOMIC_RELAXED, __HIP_MEMORY_SCOPE_AGENT); __syncthreads(); t_ = (int)__builtin_amdgcn_readfirstlane(*tl); __syncthreads(); } while (0)
        int t; NEXT_TICKET(t);
        while (t < N_LRU) { lru_unit<1>(F, l, t / LRU_CH, t % LRU_CH, INP(7), INP(8), INP(10), INP(12), INP(13)); NEXT_TICKET(t); }
        while (t < N_ALL) { const int u = t - N_LRU; const int qb = 16 - u / 32, bh = u % 32, lb = bh >> 3, h = bh & 7;
            attn_body::attn_unit<16>(lb, h, qb, (const attn_body::bf16*)proj + QF_OFF, (const attn_body::bf16*)proj + KF_OFF, (const attn_body::bf16*)proj + VF_OFF, (attn_body::bf16*)oc + 512,
                                    (const float*)(ws + WS_DK) + (size_t)(lb * 8 + h) * 4352, (char*)lds, wv);
            NEXT_TICKET(t); }
#undef NEXT_TICKET
    }
    if constexpr (ST == ST_S3) {
                    pg8::Gemm g{(const pg8::bf16_t*)oc, (const pg8::bf16_t*)(ws + wo + WS_WB)};
                    typedef pg8::OrderS3 Ord; Ord S; S.init(F.G, F.bid);
                    pg8::EpiBranch E{(const pg8::bf16_t*)proj, (pg8::bf16_t*)(mg + (size_t)grow0 * DMODEL), (pg8::bf16_t*)(ws + WS_PART) + (size_t)half * 3 * 64 * 1024};

pg8::gemm_phase<pg8::EpiBranch, Ord, true, true, 512, 1536, 512, 4>(F.lds, g, S, E, wv);
    }
    if constexpr (ST == ST_G4) {
                zero_u64(F, ssqB, MP);
                pg8::Gemm g{(const pg8::bf16_t*)mg, (const pg8::bf16_t*)(ws + wo + WS_WOUT)};
                typedef pg8::OrderTailK<4> Ord; Ord S; S.init(F.G, F.bid);
                pg8::EpiRes E{F.out, (float*)(ws + WS_HMETA), (pg8::bf16_t*)hb, ssqA, (float*)(ws + WS_PARTK), (DUP == ST && rep == 0) ? 0.f : 1.f};

pg8::gemm_phase<pg8::EpiRes, Ord, true, true, 1024, 1024, 0, 0, 256>(F.lds, g, S, E, wv);
    }
    if constexpr (ST == ST_G5) {
                pg8::Gemm g{(const pg8::bf16_t*)hb, (const pg8::bf16_t*)(ws + wo + WS_WFFI)};
                typedef pg8::Order<129, 22, 1> Ord; Ord S; S.init(F.G, F.bid);
                pg8::EpiSwiglu E{(pg8::bf16_t*)proj, ssqA};

pg8::gemm_phase<pg8::EpiSwiglu, Ord, true, true, 1024, 1024, 0, 0>(F.lds, g, S, E, wv);
                if (l < 3 && rep != 0) wconv_phase(F, l + 1, 22, INP(3), INP(4), INP(9), INP(11), INP(14), INP(15), INP(16), INP(17), INP(18));
    }
    if constexpr (ST == ST_G6) {
                zero_u64(F, ssqA, MP);
                pg8::Gemm g{(const pg8::bf16_t*)proj, (const pg8::bf16_t*)(ws + wo + WS_WFFO)};
                typedef pg8::OrderTailK<11> Ord; Ord S; S.init(F.G, F.bid);
                pg8::EpiRes E{F.out, (float*)(ws + WS_HMETA), (pg8::bf16_t*)hb, ssqB, (float*)(ws + WS_PARTK), (DUP == ST && rep == 0) ? 0.f : 1.f};

pg8::gemm_phase<pg8::EpiRes, Ord, true, true, 2816, 2816, 0, 0, 256>(F.lds, g, S, E, wv);
    }
}
template <int ST> __global__ void __launch_bounds__(NWAVES * 64, 2) k_stage(Args args, int l, int half) {
    extern __shared__ __attribute__((aligned(16))) unsigned char lds[];
    run_stage<ST>(lds, l, half, __builtin_amdgcn_readfirstlane(threadIdx.x >> 6));
}

#if ONE_LAUNCH
#define RUN(ST, l_, h_) do { int nrep_ = (DUP == ST) ? 2 : 1; if (DUP == ST) asm volatile("" : "+s"(nrep_)); for (int rep_ = 0; rep_ < nrep_; ++rep_) { run_stage<ST>(lds, l_, h_, wv, (DUP == ST) ? rep_ : 1); SEAM(); } } while (0)
#define SEAM() do { XcdBarrier b_; b_.bar = (unsigned*)((unsigned char*)karg_ptr(168) + WS_CTL) + CW_BAR; { unsigned x_ = xb_xcc_id(); asm volatile("" : "+s"(x_)); b_.x = x_; } b_.st = MISC + 8; xcd_barrier(b_); } while (0)
__global__ void __launch_bounds__(NWAVES * 64, 2) fwd_kernel(Args args) {
    extern __shared__ __attribute__((aligned(16))) unsigned char lds[];
    const int wv = __builtin_amdgcn_readfirstlane(threadIdx.x >> 6);
    volatile LAS unsigned* MISC = (volatile LAS unsigned*)((LAS unsigned char*)lds + MISC_OFF);
    for (int u = threadIdx.x; u < (LDS_BYTES - RING_BYTES) / 4; u += NWAVES * 64) ((LAS unsigned*)((LAS unsigned char*)lds + RING_BYTES))[u] = 0u;
    __syncthreads();
    (void)xcd_barrier_post((unsigned*)(args.ws + WS_CTL) + CW_BAR, MISC + 8);
    run_stage<ST_INIT>(lds, 0, 0, wv);
    __threadfence(); cooperative_groups::this_grid().sync(); SEAM();
#define HALF_(l_, h_) RUN(ST_G1, l_, h_); RUN(ST_S1, l_, h_); RUN(ST_S2, l_, h_); RUN(ST_S3, l_, h_);
#define LAYER_(l_) HALF_(l_, 0) HALF_(l_, 1) RUN(ST_FIX, l_, 0); RUN(ST_G4, l_, 0); RUN(ST_FIXK4, l_, 0); RUN(ST_G5, l_, 0); RUN(ST_G6, l_, 0); RUN(ST_FIXK6, l_, 0);
    LAYER_(0) LAYER_(1) LAYER_(2) LAYER_(3)
    run_stage<ST_FINAL>(lds, 0, 0, wv);
}
#endif
template <int ST> static void launch_stage(const Args& a, int l, int half, int grid, hipStream_t stream) {
    static bool attr = false;
    if (!attr) { (void)hipFuncSetAttribute((const void*)k_stage<ST>, hipFuncAttributeMaxDynamicSharedMemorySize, LDS_BYTES); attr = true; }
    hipLaunchKernelGGL(k_stage<ST>, dim3(grid), dim3(NWAVES * 64), LDS_BYTES, stream, a, l, half);
}
extern "C" void kernel_launch(void* const* d_in, const int* in_sizes, int n_in, void* d_out, int out_size, void* d_ws, size_t ws_size, hipStream_t stream) {
    static int grid = 0;
    if (grid == 0) {
        if (n_in != 20 || out_size != 32768 * 1024 || ws_size < WS_END) { fprintf(stderr, "kernel_launch: unexpected shapes (n_in %d out %d ws %zu need %zu)\n", n_in, out_size, ws_size, (size_t)WS_END); grid = -1; return; }
        int dev = 0, cus = 0;
        (void)hipGetDevice(&dev); (void)hipDeviceGetAttribute(&cus, hipDeviceAttributeMultiprocessorCount, dev);
        grid = cus > 0 ? cus : 256;
    }
    if (grid < 0) return;
    (void)hipMemsetAsync((char*)d_ws + WS_CTL, 0, CTL_ZERO_BYTES, stream);
    Args a{};
    for (int i = 0; i < 20; ++i) a.in[i] = (const float*)d_in[i];
    a.out = (float*)d_out; a.ws = (unsigned char*)d_ws;
#if ONE_LAUNCH
    static bool attr = false;
    if (!attr) { (void)hipFuncSetAttribute((const void*)fwd_kernel, hipFuncAttributeMaxDynamicSharedMemorySize, LDS_BYTES); attr = true; }
    void* kargs[] = {&a};
    hipError_t e = hipLaunchCooperativeKernel((const void*)fwd_kernel, dim3(grid), dim3(NWAVES * 64), kargs, LDS_BYTES, stream);
    if (e != hipSuccess) fprintf(stderr, "cooperative launch failed: %s (grid %d)\n", hipGetErrorString(e), grid);
#else
    launch_stage<ST_INIT>(a, 0, 0, grid, stream);
    for (int l = 0; l < 4; ++l) {
        if (l > 0) launch_stage<ST_WCONV>(a, l, 0, grid, stream);
        for (int half = 0; half < 2; ++half) { launch_stage<ST_G1>(a, l, half, grid, stream); launch_stage<ST_S1>(a, l, half, grid, stream); launch_stage<ST_S2>(a, l, half, grid, stream); launch_stage<ST_S3>(a, l, half, grid, stream); }
        launch_stage<ST_G4>(a, l, 0, grid, stream); launch_stage<ST_G5>(a, l, 0, grid, stream); launch_stage<ST_G6>(a, l, 0, grid, stream);
    }
    launch_stage<ST_FINAL>(a, 0, 0, grid, stream);
#endif
}
```

```cpp
#include <hip/hip_runtime.h>
#include <hip/hip_cooperative_groups.h>
#include <cstdio>
#include <cstdint>
__device__ __forceinline__ int otid(int wv) { int w_ = wv; asm volatile("" : "+s"(w_)); int ln; asm volatile("v_mbcnt_lo_u32_b32 %0, -1, 0\n\tv_mbcnt_hi_u32_b32 %0, -1, %0" : "=v"(ln)); __builtin_assume(w_ >= 0 && w_ < 8); __builtin_assume(ln >= 0 && ln < 64); return w_ * 64 + ln; }
__device__ __forceinline__ float bperm_f(int srclane, float v) { return __int_as_float(__builtin_amdgcn_ds_bpermute(srclane << 2, __float_as_int(v))); }
typedef const float* cfp_t;
__device__ __forceinline__ cfp_t karg_ptr(int off) { asm volatile("" : "+s"(off)); const __attribute__((address_space(4))) char* b = (const __attribute__((address_space(4))) char*)__builtin_amdgcn_kernarg_segment_ptr(); return *(const __attribute__((address_space(4))) cfp_t*)(b + off); }
namespace pg8 {
#define PG8_LAS __attribute__((address_space(3)))
typedef unsigned short bf16_t;
typedef short bf16x8 __attribute__((ext_vector_type(8)));
typedef float f32x4 __attribute__((ext_vector_type(4)));
typedef unsigned u32x4 __attribute__((ext_vector_type(4)));
constexpr int BM = 256, BK = 64, HALF = 128, HTB = HALF * BK * 2  , STAGE_BYTES = 8 * HTB, NXCD = 8, WGM = 6;

__host__ __device__ __forceinline__ int lds_byte(int r, int c) { const int st = (r >> 4) * 2 + (c >> 5), rr = r & 15, cc = c & 31, ob = rr * 64 + cc * 2; return st * 1024 + (ob ^ (((ob >> 9) & 1) << 5)); }
__host__ __device__ __forceinline__ void stage_rc(int b, int& R, int& C) { const int st = b / 1024, sb = b % 1024, swz = sb ^ (((sb >> 9) & 1) << 5); R = (st >> 1) * 16 + swz / 64; C = (st & 1) * 32 + (swz % 64) / 2; }
__host__ __device__ __forceinline__ int perm32(int rho) { const int n = rho >> 4, i = rho & 15; return 8 * (i >> 2) + 4 * n + (i & 3); }

struct Unit { int pm, pn, g, part; };
struct Gemm { const bf16_t* A; const bf16_t* Bt; };

template <int nM, int nN, int NG> struct Order {
    static constexpr int nwg = nM * nN;
    int G, c;
    __device__ void init(int G_, int c_) { G = G_; c = c_; }
    __device__ bool next(int i, Unit& u) const {
        const int ti = (NG == 1) ? i : i / NG; u.g = (NG == 1) ? 0 : i - ti * NG; u.part = 0;
        const long L = (long)ti * G + c; if (L >= nwg) return false;
        int wgid = (int)L; { constexpr int q = nwg / NXCD, r = nwg % NXCD; const int xcd = wgid % NXCD, off = wgid / NXCD; wgid = (xcd < r ? xcd * (q + 1) : r * (q + 1) + (xcd - r) * q) + off; }
        constexpr int nig = WGM * nN; const int gid = wgid / nig, fm = gid * WGM, gsz = (nM - fm) < WGM ? (nM - fm) : WGM;
        u.pm = fm + ((wgid % nig) % gsz); u.pn = (wgid % nig) / gsz; return true;
    }
    __device__ __forceinline__ void a_ready(const Unit&) const {}
    __device__ __forceinline__ void done(const Unit&) const {}
};
struct OrderS3 {
    int G, c;
    __device__ void init(int G_, int c_) { G = G_; c = c_; }
    __device__ __forceinline__ bool next(int i, Unit& u) const {
        constexpr int nM = 64, nN = 4, nwg = nM * nN;
        const int nmain = (c < nwg) ? ((nwg - 1 - c) / G + 1) : 0;
        const bool mainu = i < 3 * nmain;
        const int ti = i / 3, gm = i - ti * 3;
        int wgid = ti * G + c; { constexpr int q = nwg / NXCD, r = nwg % NXCD; const int xcd = wgid % NXCD, off = wgid / NXCD; wgid = (xcd < r ? xcd * (q + 1) : r * (q + 1) + (xcd - r) * q) + off; }
        constexpr int nig = WGM * nN; const int gid = wgid / nig, fm = gid * WGM, gsz = (nM - fm) < WGM ? (nM - fm) : WGM;
        const int pm_m = fm + ((wgid % nig) % gsz), pn_m = (wgid % nig) / gsz;
        const int j = (i - 3 * nmain) * G + c, pn_l = j / 3, g_l = j - pn_l * 3;
        u.pm = mainu ? pm_m : 64; u.pn = mainu ? pn_m : pn_l; u.g = mainu ? gm : g_l; u.part = mainu ? 0 : 1;
        return mainu || j < 12;
    }
    __device__ __forceinline__ void a_ready(const Unit&) const {}
    __device__ __forceinline__ void done(const Unit&) const {}
};
template <int NKC> struct OrderTailK {
    int G, c;
    __device__ void init(int G_, int c_) { G = G_; c = c_; }
    __device__ __forceinline__ bool next(int i, Unit& u) const {
        constexpr int nM = 128, nN = 4, nwg = nM * nN;
        const int nmain = (c < nwg) ? ((nwg - 1 - c) / G + 1) : 0;
        const bool mainu = i < nmain;
        int wgid = i * G + c; { constexpr int q = nwg / NXCD, r = nwg % NXCD; const int xcd = wgid % NXCD, off = wgid / NXCD; wgid = (xcd < r ? xcd * (q + 1) : r * (q + 1) + (xcd - r) * q) + off; }
        constexpr int nig = WGM * nN; const int gid = wgid / nig, fm = gid * WGM, gsz = (nM - fm) < WGM ? (nM - fm) : WGM;
        const int pm_m = fm + ((wgid % nig) % gsz), pn_m = (wgid % nig) / gsz;
        const int j = (i - nmain) * G + c, pn_l = j / NKC, g_l = j - pn_l * NKC;
        u.pm = mainu ? pm_m : 128; u.pn = mainu ? pn_m : pn_l; u.g = mainu ? 0 : g_l; u.part = mainu ? 0 : 1;
        return mainu || j < 4 * NKC;
    }
    __device__ __forceinline__ void a_ready(const Unit&) const {}
    __device__ __forceinline__ void done(const Unit&) const {}
};
__device__ __forceinline__ unsigned cvt_pk_bf16(float lo, float hi) { unsigned r; asm volatile("v_cvt_pk_bf16_f32 %0, %1, %2" : "=v"(r) : "v"(lo), "v"(hi)); return r; }
__device__ __forceinline__ float bf_lo(unsigned w) { return __uint_as_float(w << 16); }
__device__ __forceinline__ float bf_hi(unsigned w) { return __uint_as_float(w & 0xffff0000u); }
__device__ __forceinline__ float sigmoid_f(float x) { return __builtin_amdgcn_rcpf(1.f + __expf(-x)); }
constexpr int M_TOK = 32896, T_TOK = 4112, NPROJ = 6656, GATE_OFF = 3328, DFF = 2816, DM = 1024, FL_LD = 16896;

#define PG8_PIN4(a, b, c, d) asm volatile("" :: "v"(a), "v"(b), "v"(c), "v"(d))
__device__ __forceinline__ float rs_of(unsigned long long q) { return rsqrtf((float)q * (1.0f / (1024.0f * 1048576.0f)) + 1e-6f); }
struct EpiProj {
    static constexpr bool PERM = true, AFTER_DRAIN = false;
    bf16_t* P; float* fl; const unsigned long long* ssq; int grow0;
    __device__ __forceinline__ void operator()(const f32x4 (&acc)[2][2][4][2], const Unit& u, int wr, int wc, int fr, int fq) const {
        const int row0 = u.pm * BM + wr * 64 + fr, col0 = u.pn * BM + wc * 32 + 8 * fq;
        unsigned long long q[2][4];
#pragma unroll
        for (int ai = 0; ai < 2; ++ai)
#pragma unroll
            for (int m = 0; m < 4; ++m) { const int grow = row0 + ai * HALF + m * 16 + grow0; q[ai][m] = ssq[grow < M_TOK ? grow : M_TOK - 1]; }
        PG8_PIN4(q[0][0], q[0][1], q[0][2], q[0][3]); PG8_PIN4(q[1][0], q[1][1], q[1][2], q[1][3]);
#pragma unroll
        for (int ai = 0; ai < 2; ++ai)
#pragma unroll
            for (int m = 0; m < 4; ++m) { const int lrow = row0 + ai * HALF + m * 16, grow = lrow + grow0;
                const float s = (grow < M_TOK) ? rs_of(q[ai][m]) : 0.f;
                if (u.pn < 25) {
#pragma unroll
                    for (int bj = 0; bj < 2; ++bj) { const f32x4 v0 = acc[ai][bj][m][0] * s, v1 = acc[ai][bj][m][1] * s;
                        u32x4 w; w.x = cvt_pk_bf16(v0[0], v0[1]); w.y = cvt_pk_bf16(v0[2], v0[3]); w.z = cvt_pk_bf16(v1[0], v1[1]); w.w = cvt_pk_bf16(v1[2], v1[3]);
                        *(u32x4*)(P + (size_t)lrow * NPROJ + col0 + bj * HALF) = w; }
                } else if (wc == 0 && fq == 0) {
                    *(f32x4*)(fl + (size_t)lrow * 8) = acc[ai][0][m][0] * s; *(f32x4*)(fl + (size_t)lrow * 8 + 4) = acc[ai][0][m][1] * s; }
            }
    }
};
struct EpiBranch {
    static constexpr bool PERM = true, AFTER_DRAIN = false;
    const bf16_t* P; bf16_t* MG; bf16_t* PART;
    __device__ __forceinline__ void operator()(const f32x4 (&acc)[2][2][4][2], const Unit& u, int wr, int wc, int fr, int fq) const {
        const int row0 = u.pm * BM + wr * 64 + fr, col0 = u.pn * BM + wc * 32 + 8 * fq;
#pragma unroll
        for (int ai = 0; ai < 2; ++ai) {
            if (u.part && (ai != 0 || wr != 0)) continue;
            u32x4 gw[4][2], pw[4][2];
#pragma unroll
            for (int m = 0; m < 4; ++m)
#pragma unroll
                for (int bj = 0; bj < 2; ++bj) { const int lrow = row0 + ai * HALF + m * 16, c = col0 + bj * HALF;
                    gw[m][bj] = *(const u32x4*)(P + (size_t)lrow * NPROJ + GATE_OFF + u.g * DM + c);
                    const u32x4 pv_ = *(const u32x4*)(MG + (size_t)lrow * DM + c);
                    pw[m][bj] = (u.g > 0 && !u.part) ? pv_ : (u32x4){0u, 0u, 0u, 0u}; }
            PG8_PIN4(gw[0][0], gw[0][1], gw[1][0], gw[1][1]); PG8_PIN4(gw[2][0], gw[2][1], gw[3][0], gw[3][1]);
            PG8_PIN4(pw[0][0], pw[0][1], pw[1][0], pw[1][1]); PG8_PIN4(pw[2][0], pw[2][1], pw[3][0], pw[3][1]);
#pragma unroll
            for (int m = 0; m < 4; ++m)
#pragma unroll
                for (int bj = 0; bj < 2; ++bj) { const int lrow = row0 + ai * HALF + m * 16, c = col0 + bj * HALF; const u32x4 g4 = gw[m][bj], p4 = pw[m][bj];
                    f32x4 v0 = acc[ai][bj][m][0], v1 = acc[ai][bj][m][1];
                    v0[0] = v0[0] * sigmoid_f(bf_lo(g4.x)) + bf_lo(p4.x); v0[1] = v0[1] * sigmoid_f(bf_hi(g4.x)) + bf_hi(p4.x); v0[2] = v0[2] * sigmoid_f(bf_lo(g4.y)) + bf_lo(p4.y); v0[3] = v0[3] * sigmoid_f(bf_hi(g4.y)) + bf_hi(p4.y);
                    v1[0] = v1[0] * sigmoid_f(bf_lo(g4.z)) + bf_lo(p4.z); v1[1] = v1[1] * sigmoid_f(bf_hi(g4.z)) + bf_hi(p4.z); v1[2] = v1[2] * sigmoid_f(bf_lo(g4.w)) + bf_lo(p4.w); v1[3] = v1[3] * sigmoid_f(bf_hi(g4.w)) + bf_hi(p4.w);
                    u32x4 w; w.x = cvt_pk_bf16(v0[0], v0[1]); w.y = cvt_pk_bf16(v0[2], v0[3]); w.z = cvt_pk_bf16(v1[0], v1[1]); w.w = cvt_pk_bf16(v1[2], v1[3]);
                    bf16_t* dst = u.part ? PART + ((size_t)u.g * 64 + (lrow - 64 * BM)) * DM + c : MG + (size_t)lrow * DM + c;
                    *(u32x4*)dst = w; }
        }
    }
};
struct EpiRes {
    static constexpr bool PERM = true, AFTER_DRAIN = false;
    float* hout; float* hmeta; bf16_t* hb; unsigned long long* ssq; float* partk; float mul;
    __device__ __forceinline__ void operator()(const f32x4 (&acc)[2][2][4][2], const Unit& u, int wr, int wc, int fr, int fq) const {
        const int row0 = u.pm * BM + wr * 64 + fr, col0 = u.pn * BM + wc * 32 + 8 * fq;
        if (u.part) {
            float* pp = partk + ((size_t)u.g * 128 + wr * 64 + fr) * DM + col0;
#pragma unroll
            for (int m = 0; m < 4; ++m)
#pragma unroll
                for (int bj = 0; bj < 2; ++bj)
#pragma unroll
                    for (int n = 0; n < 2; ++n) *(f32x4*)(pp + (size_t)m * 16 * DM + bj * HALF + n * 4) = acc[0][bj][m][n];
        } else
#pragma unroll
        for (int ai = 0; ai < 2; ++ai) {
            f32x4 hv[4][2][2]; float* hp0, *hp1, *hp2, *hp3;
#pragma unroll
            for (int m = 0; m < 4; ++m) { int grow = row0 + ai * HALF + m * 16; grow = grow < M_TOK ? grow : M_TOK - 1; const int b = grow / T_TOK, t = grow - b * T_TOK;
                float* hpm = ((t < 16) ? hmeta + (size_t)(b * 16 + t) * DM : hout + ((size_t)b * 4096 + (t - 16)) * DM) + col0;
                if (m == 0) hp0 = hpm; else if (m == 1) hp1 = hpm; else if (m == 2) hp2 = hpm; else hp3 = hpm;
#pragma unroll
                for (int bj = 0; bj < 2; ++bj)
#pragma unroll
                    for (int n = 0; n < 2; ++n) hv[m][bj][n] = *(const f32x4*)(hpm + bj * HALF + n * 4); }
#pragma unroll
            for (int m = 0; m < 4; ++m) PG8_PIN4(hv[m][0][0], hv[m][0][1], hv[m][1][0], hv[m][1][1]);
#pragma unroll
            for (int m = 0; m < 4; ++m) { const int grow = row0 + ai * HALF + m * 16; const bool ok = grow < M_TOK; float ss = 0.f; float* hpm = (m == 0) ? hp0 : (m == 1) ? hp1 : (m == 2) ? hp2 : hp3;
#pragma unroll
                for (int bj = 0; bj < 2; ++bj) { const f32x4 o0 = hv[m][bj][0] + acc[ai][bj][m][0] * mul, o1 = hv[m][bj][1] + acc[ai][bj][m][1] * mul;
                    ss += (o0[0] * o0[0] + o0[1] * o0[1]) + (o0[2] * o0[2] + o0[3] * o0[3]) + (o1[0] * o1[0] + o1[1] * o1[1]) + (o1[2] * o1[2] + o1[3] * o1[3]);
                    u32x4 w; w.x = cvt_pk_bf16(o0[0], o0[1]); w.y = cvt_pk_bf16(o0[2], o0[3]); w.z = cvt_pk_bf16(o1[0], o1[1]); w.w = cvt_pk_bf16(o1[2], o1[3]);
                    if (ok) { *(f32x4*)(hpm + bj * HALF) = o0; *(f32x4*)(hpm + bj * HALF + 4) = o1; *(u32x4*)(hb + (size_t)grow * DM + col0 + bj * HALF) = w; } }
                { const int ln_ = fq * 16 + fr; ss += bperm_f(ln_ ^ 16, ss); ss += bperm_f(ln_ ^ 32, ss); }
                if (fq == 0 && ok) atomicAdd(ssq + grow, (unsigned long long)(ss * (1048576.0f * mul)));
            }
        }
    }
};
struct EpiSwiglu {
    static constexpr bool PERM = true, AFTER_DRAIN = false;
    bf16_t* ACT; const unsigned long long* ssq;
    __device__ __forceinline__ void operator()(const f32x4 (&acc)[2][2][4][2], const Unit& u, int wr, int wc, int fr, int fq) const {
        const int row0 = u.pm * BM + wr * 64 + fr, col0 = u.pn * HALF + wc * 32 + 8 * fq;
        unsigned long long q[2][4];
#pragma unroll
        for (int ai = 0; ai < 2; ++ai)
#pragma unroll
            for (int m = 0; m < 4; ++m) { const int grow = row0 + ai * HALF + m * 16; q[ai][m] = ssq[grow < M_TOK ? grow : M_TOK - 1]; }
        PG8_PIN4(q[0][0], q[0][1], q[0][2], q[0][3]); PG8_PIN4(q[1][0], q[1][1], q[1][2], q[1][3]);
#pragma unroll
        for (int ai = 0; ai < 2; ++ai)
#pragma unroll
            for (int m = 0; m < 4; ++m) { const int grow = row0 + ai * HALF + m * 16;
                const float s = (grow < M_TOK) ? rs_of(q[ai][m]) : 0.f;
                float o[8];
#pragma unroll
                for (int n = 0; n < 2; ++n)
#pragma unroll
                    for (int j = 0; j < 4; ++j) { const float gt = acc[ai][0][m][n][j] * s, up = acc[ai][1][m][n][j] * s; o[4 * n + j] = gt * sigmoid_f(gt) * up; }
                u32x4 w; w.x = cvt_pk_bf16(o[0], o[1]); w.y = cvt_pk_bf16(o[2], o[3]); w.z = cvt_pk_bf16(o[4], o[5]); w.w = cvt_pk_bf16(o[6], o[7]);
                *(u32x4*)(ACT + (size_t)grow * DFF + col0) = w; }
    }
};

template <class Epi, class Sched, bool ALIGN_EPI, bool SP2, int GK, int LDA, int AGOFF, int BGT, int KC = 0>
__device__ __forceinline__ void gemm_phase(PG8_LAS unsigned char* lds, const Gemm g, const Sched& S, const Epi& E, int wv) {
    const int tid = otid(wv), wid = __builtin_amdgcn_readfirstlane(tid >> 6), lane = tid & 63, wr = wid >> 2, wc = wid & 3, fr = lane & 15, fq = lane >> 4;
    constexpr int K = GK, nt = K / BK;
    unsigned voffA[2], voffB[2];
#pragma unroll
    for (int i = 0; i < 2; ++i) { int R, C; stage_rc(tid * 16 + i * 8192, R, C); const int Rb = Epi::PERM ? ((R & ~31) + perm32(R & 31)) : R;
        voffA[i] = (unsigned)(R * LDA + C) * 2u; voffB[i] = (unsigned)(Rb * K + C) * 2u; }
    constexpr size_t kstep = (size_t)(BK * 2);
    constexpr size_t hstepA = (size_t)HALF * LDA * 2, hstepB = (size_t)HALF * K * 2;
    constexpr size_t tstepA = 2 * hstepA, tstepB = 2 * hstepB;
    const unsigned ldsw = (unsigned)wid * 1024u;
    const int aoff = lds_byte(wr * 64 + fr, fq * 8), boff = lds_byte(wc * 32 + fr, fq * 8);
#define PG8_SA(b, h) (((b) * 2 + (h)) * HTB)
#define PG8_SB(b, h) ((4 + (b) * 2 + (h)) * HTB)
#define PG8_STAGE(bufoff, gbase, voff) do { _Pragma("unroll") for (int _i = 0; _i < 2; ++_i) \
        __builtin_amdgcn_global_load_lds((const unsigned*)((const char*)(gbase) + (voff)[_i]), (PG8_LAS unsigned*)(lds + (bufoff) + ldsw + _i * 8192), 16, 0, 0); } while (0)
#define PG8_LDA(dst, b, h) do { _Pragma("unroll") for (int m = 0; m < 4; ++m) _Pragma("unroll") for (int k = 0; k < 2; ++k) dst[m][k] = *(const PG8_LAS bf16x8*)(lds + PG8_SA(b, h) + aoff + m * 2048 + k * 1024); } while (0)
#define PG8_LDB(dst, b, h) do { _Pragma("unroll") for (int n = 0; n < 2; ++n) _Pragma("unroll") for (int k = 0; k < 2; ++k) dst[n][k] = *(const PG8_LAS bf16x8*)(lds + PG8_SB(b, h) + boff + n * 2048 + k * 1024); } while (0)
#define PG8_MMA(ai, bj, At, Bt) do { __builtin_amdgcn_s_setprio(1); _Pragma("unroll") for (int m = 0; m < 4; ++m) _Pragma("unroll") for (int n = 0; n < 2; ++n) _Pragma("unroll") for (int k = 0; k < 2; ++k) \
        acc[ai][bj][m][n] = __builtin_amdgcn_mfma_f32_16x16x32_bf16(Bt[n][k], At[m][k], acc[ai][bj][m][n], 0, 0, 0); __builtin_amdgcn_s_setprio(0); } while (0)
#define PG8_WAIT_V(n) asm volatile("s_waitcnt vmcnt(" #n ")" ::: "memory")
#define PG8_WAIT_L(n) asm volatile("s_waitcnt lgkmcnt(" #n ")" ::: "memory")
#define PG8_BAR __builtin_amdgcn_s_barrier()
#define PG8_SCHED __builtin_amdgcn_sched_barrier(0)
    Unit cur, nxt; int ui = 0;
    if (!S.next(0, cur)) return;
    f32x4 acc[2][2][4][2];
#pragma unroll
    for (int a = 0; a < 2; ++a)
#pragma unroll
        for (int b = 0; b < 2; ++b)
#pragma unroll
            for (int m = 0; m < 4; ++m)
#pragma unroll
                for (int n = 0; n < 2; ++n) acc[a][b][m][n] = (f32x4){0.f, 0.f, 0.f, 0.f};
    bf16x8 At[4][2], B0[2][2], B1[2][2];
    const char* cA = (const char*)g.A + (size_t)cur.pm * tstepA + (size_t)cur.g * AGOFF * 2 + ((KC && cur.part) ? cur.g * (KC * 2) : 0); const char* cB = (const char*)g.Bt + (size_t)(cur.pn + cur.g * BGT) * tstepB + ((KC && cur.part) ? cur.g * (KC * 2) : 0);
    S.a_ready(cur);
    if constexpr (SP2) {
        PG8_STAGE(PG8_SB(0, 0), cB, voffB); PG8_STAGE(PG8_SB(0, 1), cB + hstepB, voffB); PG8_STAGE(PG8_SA(0, 0), cA, voffA); PG8_STAGE(PG8_SA(0, 1), cA + hstepA, voffA);
        if (wr == 1) PG8_BAR;
        PG8_WAIT_V(2); PG8_BAR;
        PG8_STAGE(PG8_SB(1, 0), cB + kstep, voffB); PG8_STAGE(PG8_SA(1, 0), cA + kstep, voffA); PG8_STAGE(PG8_SB(1, 1), cB + hstepB + kstep, voffB);
        PG8_WAIT_V(6); PG8_BAR;
    } else {
        PG8_STAGE(PG8_SB(0, 0), cB, voffB); PG8_STAGE(PG8_SA(0, 0), cA, voffA); PG8_STAGE(PG8_SB(0, 1), cB + hstepB, voffB); PG8_STAGE(PG8_SA(0, 1), cA + hstepA, voffA);
        if (wr == 1) PG8_BAR;
        PG8_WAIT_V(4); PG8_BAR;
        PG8_STAGE(PG8_SB(1, 0), cB + kstep, voffB); PG8_STAGE(PG8_SA(1, 0), cA + kstep, voffA); PG8_STAGE(PG8_SB(1, 1), cB + hstepB + kstep, voffB);
        PG8_WAIT_V(6); PG8_BAR;
    }
    for (;;) {
        const bool has_next = S.next(ui + 1, nxt);
        const char* nA = has_next ? (const char*)g.A + (size_t)nxt.pm * tstepA + (size_t)nxt.g * AGOFF * 2 + ((KC && nxt.part) ? nxt.g * (KC * 2) : 0) : cA; const char* nB = has_next ? (const char*)g.Bt + (size_t)(nxt.pn + nxt.g * BGT) * tstepB + ((KC && nxt.part) ? nxt.g * (KC * 2) : 0) : cB;
        const int ntu = (KC && cur.part) ? KC / BK : nt;
        for (int t = 0; t < ntu; t += 2) {
            const bool last = (t == ntu - 2);
            const char* a1 = cA + (size_t)(t + 1) * kstep;
            const char* a2 = last ? nA : cA + (size_t)(t + 2) * kstep; const char* b2 = last ? nB : cB + (size_t)(t + 2) * kstep;
            const char* a3 = a2 + kstep; const char* b3 = b2 + kstep;
            if (last && has_next) S.a_ready(nxt);
            if constexpr (SP2) {
            PG8_LDB(B0, 0, 0); PG8_LDB(B1, 0, 1); PG8_SCHED; PG8_LDA(At, 0, 0); PG8_STAGE(PG8_SA(1, 1), a1 + hstepA, voffA);
            PG8_WAIT_V(8); PG8_WAIT_L(0); PG8_BAR; PG8_MMA(0, 0, At, B0); PG8_MMA(0, 1, At, B1); PG8_BAR; PG8_SCHED;
            PG8_LDA(At, 0, 1); PG8_STAGE(PG8_SB(0, 0), b2, voffB); PG8_STAGE(PG8_SB(0, 1), b2 + hstepB, voffB); PG8_STAGE(PG8_SA(0, 0), a2, voffA);
            PG8_WAIT_V(8); PG8_WAIT_L(0); PG8_BAR; PG8_MMA(1, 0, At, B0); PG8_MMA(1, 1, At, B1); PG8_BAR; PG8_SCHED;
            PG8_LDB(B0, 1, 0); PG8_LDB(B1, 1, 1); PG8_SCHED; PG8_LDA(At, 1, 0); PG8_STAGE(PG8_SA(0, 1), a2 + hstepA, voffA);
            PG8_WAIT_V(8); PG8_WAIT_L(0); PG8_BAR; PG8_MMA(0, 0, At, B0); PG8_MMA(0, 1, At, B1); PG8_BAR; PG8_SCHED;
            PG8_LDA(At, 1, 1); PG8_STAGE(PG8_SB(1, 0), b3, voffB); PG8_STAGE(PG8_SB(1, 1), b3 + hstepB, voffB); PG8_STAGE(PG8_SA(1, 0), a3, voffA);
            PG8_WAIT_V(8); PG8_WAIT_L(0); PG8_BAR; PG8_MMA(1, 0, At, B0); PG8_MMA(1, 1, At, B1); PG8_BAR; PG8_SCHED;
            } else {
            PG8_LDB(B0, 0, 0); PG8_SCHED; PG8_LDA(At, 0, 0); PG8_STAGE(PG8_SA(1, 1), a1 + hstepA, voffA);
            PG8_WAIT_L(8); PG8_BAR; PG8_WAIT_L(0); PG8_MMA(0, 0, At, B0); PG8_BAR; PG8_SCHED;
            PG8_LDB(B1, 0, 1); PG8_STAGE(PG8_SB(0, 0), b2, voffB);
            PG8_BAR; PG8_WAIT_L(0); PG8_MMA(0, 1, At, B1); PG8_BAR;
            PG8_LDA(At, 0, 1); PG8_STAGE(PG8_SA(0, 0), a2, voffA);
            PG8_BAR; PG8_WAIT_L(0); PG8_MMA(1, 0, At, B0); PG8_BAR; PG8_SCHED;
            PG8_STAGE(PG8_SB(0, 1), b2 + hstepB, voffB);
            PG8_WAIT_V(6); PG8_BAR; PG8_MMA(1, 1, At, B1); PG8_BAR;
            PG8_LDB(B0, 1, 0); PG8_SCHED; PG8_LDA(At, 1, 0); PG8_STAGE(PG8_SA(0, 1), a2 + hstepA, voffA);
            PG8_WAIT_L(8); PG8_BAR; PG8_WAIT_L(0); PG8_MMA(0, 0, At, B0); PG8_BAR; PG8_SCHED;
            PG8_LDB(B1, 1, 1); PG8_STAGE(PG8_SB(1, 0), b3, voffB);
            PG8_BAR; PG8_WAIT_L(0); PG8_MMA(0, 1, At, B1); PG8_BAR;
            PG8_LDA(At, 1, 1); PG8_STAGE(PG8_SA(1, 0), a3, voffA);
            PG8_BAR; PG8_WAIT_L(0); PG8_MMA(1, 0, At, B0); PG8_BAR; PG8_SCHED;
            PG8_STAGE(PG8_SB(1, 1), b3 + hstepB, voffB);
            PG8_WAIT_V(6); PG8_BAR; PG8_MMA(1, 1, At, B1); PG8_BAR;
            }
        }
        if constexpr (ALIGN_EPI) { if (wr == 0) PG8_BAR; }
        if constexpr (!Epi::AFTER_DRAIN) { E(acc, cur, wr, wc, fr, fq); S.done(cur); }
        if (!has_next) break;
#pragma unroll
        for (int a = 0; a < 2; ++a)
#pragma unroll
            for (int b = 0; b < 2; ++b)
#pragma unroll
                for (int m = 0; m < 4; ++m)
#pragma unroll
                    for (int n = 0; n < 2; ++n) acc[a][b][m][n] = (f32x4){0.f, 0.f, 0.f, 0.f};
        cur = nxt; cA = nA; cB = nB; ++ui;
        if constexpr (ALIGN_EPI) { if (wr == 1) PG8_BAR; }
    }
    PG8_WAIT_V(0);
    if constexpr (!ALIGN_EPI) { if (wr == 0) PG8_BAR; }
    PG8_BAR;
    if constexpr (Epi::AFTER_DRAIN) { E.fused(acc, cur, wr, wc, fr, fq, lds, wid, lane); S.done(cur); }
#undef PG8_SA
#undef PG8_SB
#undef PG8_STAGE
#undef PG8_LDA
#undef PG8_LDB
#undef PG8_MMA
#undef PG8_WAIT_V
#undef PG8_WAIT_L
#undef PG8_BAR
#undef PG8_SCHED
}
}

#include <hip/hip_bf16.h>
#include <cmath>
namespace attn_body {
using bf16=__hip_bfloat16;
using bf16x8=__attribute__((ext_vector_type(8)))short;
using s16x4=__attribute__((ext_vector_type(4)))short;
using f32x16=__attribute__((ext_vector_type(16)))float;
using u32x4=__attribute__((ext_vector_type(4)))unsigned;
constexpr int D=64,PQ=6656,PO=1536,TTOK=4112;
constexpr int NW=8,QBLK=32,QB=QBLK*NW,KVBLK=64,NQB=17;
__device__ __forceinline__ int crow(int r,int hi){return (r&3)+8*(r>>2)+4*hi;}
#define SBAR() __builtin_amdgcn_sched_barrier(0)
__device__ __forceinline__ void cmask(f32x16&p0,f32x16&p1,int jb,int qrel,int hi){
  const float NEG=-INFINITY; int kb=64*jb+4*hi;
  #pragma unroll
  for(int r=0;r<16;++r){int kv=kb+(r&3)+8*(r>>2); if(kv>qrel)p0[r]=NEG; if(kv+32>qrel)p1[r]=NEG;}
}

constexpr int NSLOT=3, SLOTB=8192;
constexpr int LDS_K=0, LDS_V=NSLOT*SLOTB, LDS_WS=2*NSLOT*SLOTB, LDS_OST=LDS_WS+NW*64*4, LDS_BYTES=LDS_OST+NW*4096, LDS_DK=LDS_BYTES, LDS_END=LDS_DK+66*256;
constexpr float C2=0.125f*1.4426950408889634f;
__device__ __forceinline__ void glds16(const void*gsrc,unsigned lds_dst){unsigned keep;
  asm volatile("s_mov_b32 %0, m0\n\ts_mov_b32 m0, %2\n\ts_nop 0\n\tglobal_load_lds_dwordx4 %1, off\n\ts_mov_b32 m0, %0":"=&s"(keep):"v"(gsrc),"s"(lds_dst):"memory");}
__device__ __forceinline__ float max3f(float a,float b,float c){float r;asm("v_max3_f32 %0, %1, %2, %3":"=v"(r):"v"(a),"v"(b),"v"(c));return r;}
__device__ __forceinline__ float max2f(float a,float b){float r;asm("v_max_f32_e32 %0, %1, %2":"=v"(r):"v"(a),"v"(b));return r;}
__device__ __forceinline__ float fadd_s(float a,float b){float r;asm("v_add_f32_e32 %0, %1, %2":"=v"(r):"v"(a),"v"(b));return r;}
__device__ __forceinline__ float fsub_s(float a,float b){float r;asm("v_sub_f32_e32 %0, %1, %2":"=v"(r):"v"(a),"v"(b));return r;}
typedef float f32x2_t __attribute__((ext_vector_type(2))); typedef __bf16 bf16x2_t __attribute__((ext_vector_type(2)));
__device__ __forceinline__ unsigned cvtpk_s(float lo,float hi){f32x2_t v={lo,hi};bf16x2_t b=__builtin_convertvector(v,bf16x2_t);return __builtin_bit_cast(unsigned,b);}
#define WAIT_BAR(N) asm volatile("s_waitcnt vmcnt(" #N ") lgkmcnt(0)\n\ts_barrier":::"memory")

__device__ __forceinline__ void qkt(f32x16&p0,f32x16&p1,const char*Kslot,const bf16x8*qr,const f32x16&negm,int r32,int hi){
  const char*kb=Kslot+hi*1024+r32*16;
  #pragma unroll
  for(int d0=0;d0<4;++d0){
    const bf16x8 b0=*reinterpret_cast<const bf16x8*>(kb+d0*2048);
    const bf16x8 b1=*reinterpret_cast<const bf16x8*>(kb+d0*2048+512);
    if(d0==0){p0=__builtin_amdgcn_mfma_f32_32x32x16_bf16(b0,qr[0],negm,0,0,0);p1=__builtin_amdgcn_mfma_f32_32x32x16_bf16(b1,qr[0],negm,0,0,0);}
    else{p0=__builtin_amdgcn_mfma_f32_32x32x16_bf16(b0,qr[d0],p0,0,0,0);p1=__builtin_amdgcn_mfma_f32_32x32x16_bf16(b1,qr[d0],p1,0,0,0);}}
}
typedef __attribute__((address_space(3))) const char* lds_cptr;
typedef short v4i16_t __attribute__((ext_vector_type(4)));
__device__ __forceinline__ void kload8(bf16x8*kf,lds_cptr kp){
  kf[0]=*(const __attribute__((address_space(3))) bf16x8*)(kp);      kf[1]=*(const __attribute__((address_space(3))) bf16x8*)(kp+512);
  kf[2]=*(const __attribute__((address_space(3))) bf16x8*)(kp+2048); kf[3]=*(const __attribute__((address_space(3))) bf16x8*)(kp+2560);
  kf[4]=*(const __attribute__((address_space(3))) bf16x8*)(kp+4096); kf[5]=*(const __attribute__((address_space(3))) bf16x8*)(kp+4608);
  kf[6]=*(const __attribute__((address_space(3))) bf16x8*)(kp+6144); kf[7]=*(const __attribute__((address_space(3))) bf16x8*)(kp+6656);
}
__device__ __forceinline__ void kload2(bf16x8*kf,lds_cptr kp,int j){ kf[2*j]=*(const __attribute__((address_space(3))) bf16x8*)(kp+j*2048); kf[2*j+1]=*(const __attribute__((address_space(3))) bf16x8*)(kp+j*2048+512); }
__device__ __forceinline__ s16x4 vtr(lds_cptr p){ return __builtin_bit_cast(s16x4,__builtin_amdgcn_ds_read_tr16_b64_v4i16((__attribute__((address_space(3))) v4i16_t*)p)); }
__device__ __forceinline__ float rowmax(const f32x16&p0,const f32x16&p1){
  float a=max3f(p0[0],p0[1],p1[0]),b=max3f(p0[2],p0[3],p1[1]);a=max3f(a,p1[2],p1[3]);
  #pragma unroll
  for(int r=4;r<16;r+=4){a=max3f(a,p0[r],p0[r+1]);b=max3f(b,p0[r+2],p0[r+3]);a=max3f(a,p1[r],p1[r+1]);b=max3f(b,p1[r+2],p1[r+3]);}
  const float m=max2f(a,b);
  auto rr=__builtin_amdgcn_permlane32_swap(__float_as_uint(m),__float_as_uint(m),false,false);
  return max2f(__uint_as_float(rr[0]),__uint_as_float(rr[1]));
}
__device__ __forceinline__ void pv(f32x16*o,int vb,bf16x8 pa0,bf16x8 pa1,bf16x8 pa2,bf16x8 pa3){
  #pragma unroll
  for(int d0=0;d0<2;++d0){s16x4 lo[4],hi[4];
    #pragma unroll
    for(int ks=0;ks<4;++ks){
      asm volatile("ds_read_b64_tr_b16 %0,%1 offset:%c2":"=&v"(lo[ks]):"v"(vb),"i"(d0*4096+ks*1024):"memory");
      asm volatile("ds_read_b64_tr_b16 %0,%1 offset:%c2":"=&v"(hi[ks]):"v"(vb),"i"(d0*4096+ks*1024+512):"memory");}
    asm volatile("s_waitcnt lgkmcnt(0)":::"memory");SBAR();
    #define PK(k) (bf16x8){lo[k][0],lo[k][1],lo[k][2],lo[k][3],hi[k][0],hi[k][1],hi[k][2],hi[k][3]}
    o[d0]=__builtin_amdgcn_mfma_f32_32x32x16_bf16(pa0,PK(0),o[d0],0,0,0);
    o[d0]=__builtin_amdgcn_mfma_f32_32x32x16_bf16(pa1,PK(1),o[d0],0,0,0);
    o[d0]=__builtin_amdgcn_mfma_f32_32x32x16_bf16(pa2,PK(2),o[d0],0,0,0);
    o[d0]=__builtin_amdgcn_mfma_f32_32x32x16_bf16(pa3,PK(3),o[d0],0,0,0);
    #undef PK
  }
}

#ifndef ATTN_STORE16
#define ATTN_STORE16(p,v) (*(u32x4*)(p)=(v))
#endif
template<int THRL> __device__ __forceinline__ void attn_unit(int b,int h,int qb,const bf16*Q,const bf16*__restrict__ K,const bf16*__restrict__ V,bf16*O,const float*__restrict__ dkg,char*shm,int wv){
  const int tid=otid(wv),lane=tid&63,r32=lane&31,hi=lane>>5; const int wid=__builtin_amdgcn_readfirstlane(tid>>6);
  const long rowbase=(long)b*TTOK; const int q0=qb*QB;
  const bf16*Qw=Q+(rowbase+q0+wid*QBLK)*PQ+h*D;
  const bf16*Kh=K+rowbase*PQ+h*D,*Vh=V+rowbase*PQ+h*D;
  const unsigned lds0=(unsigned)(uintptr_t)shm;
  float*wsf=(float*)(shm+LDS_WS)+wid*64;
  const bf16*ksrc=Kh+(long)lane*PQ+wid*8;
  const bf16*vsrc=Vh+(long)(16*(wid&3)+(lane>>2))*PQ+(wid>>2)*32+(lane&3)*8;
  const unsigned kdst=lds0+LDS_K+wid*1024, vdst=lds0+LDS_V+wid*1024;
  #define DMA_K(t,slot) glds16(ksrc+(long)(t)*KVBLK*PQ,(unsigned)__builtin_amdgcn_readfirstlane(kdst+(slot)))
  #define DMA_V(t,slot) glds16(vsrc+(long)(t)*KVBLK*PQ,(unsigned)__builtin_amdgcn_readfirstlane(vdst+(slot)))
  const int vb0=(int)(lds0+LDS_V)+((lane>>4)&1)*32+(lane&3)*8+(4*hi+((lane&15)>>2))*64;
  const char*Kbase=shm+LDS_K; bf16x8 kf[8];
  const lds_cptr shm3=(lds_cptr)shm; const lds_cptr kp0=shm3+LDS_K+hi*1024+r32*16; const lds_cptr vp0=shm3+LDS_V+((lane>>4)&1)*32+(lane&3)*8+(4*hi+((lane&15)>>2))*64;
  const int NT=(qb==NQB-1)?66:(q0+QB)/KVBLK; const int band0=4*qb;
  { typedef float f4_t __attribute__((ext_vector_type(4)));
    for(int i_=tid;i_<NT*16;i_+=NW*64){ const f4_t v_=*(const f4_t*)(dkg+4*i_); *(__attribute__((address_space(3))) f4_t*)(shm3+LDS_DK+16*i_)=v_; } }
  #define ADDK(P0,P1,t) do{ typedef float f4_t __attribute__((ext_vector_type(4))); const __attribute__((address_space(3))) f4_t* dq_=(const __attribute__((address_space(3))) f4_t*)(shm3+LDS_DK+(t)*256+hi*16); \
    _Pragma("unroll") for(int g_=0;g_<4;++g_){ const f4_t a_=dq_[2*g_], b_=dq_[8+2*g_]; \
      P0[4*g_]+=a_[0];P0[4*g_+1]+=a_[1];P0[4*g_+2]+=a_[2];P0[4*g_+3]+=a_[3]; P1[4*g_]+=b_[0];P1[4*g_+1]+=b_[1];P1[4*g_+2]+=b_[2];P1[4*g_+3]+=b_[3]; } }while(0)
  DMA_K(0,0);DMA_V(0,0);DMA_K(1,SLOTB);
  bf16x8 qr[4];
  #pragma unroll
  for(int d0=0;d0<4;++d0)qr[d0]=*reinterpret_cast<const bf16x8*>(&Qw[(long)r32*PQ+d0*16+hi*8]);
  const lds_cptr qpark=shm3+LDS_OST+wid*4096+lane*16;
  #pragma unroll
  for(int d0=0;d0<4;++d0)*(__attribute__((address_space(3))) bf16x8*)(qpark+d0*1024)=qr[d0];
  #define QP(k) (*(const __attribute__((address_space(3))) bf16x8*)(qpark+(k)*1024))
  float mhat=0.f,l_reg=0.f;f32x16 o[2];o[0]=f32x16{};o[1]=f32x16{};f32x16 negm=f32x16{};asm volatile("":"+v"(negm));
  const int qrel=wid*QBLK+r32;
  #define CMASK(P0,P1,t) do{int jb_=(t)-band0; if(jb_>=0)cmask(P0,P1,jb_,qrel,hi);}while(0)
  bool resc=false;
  #define START(P0,P1) do{ const float rm=rowmax(P0,P1); resc=false; \
    { const float dl=rm; mhat=fadd_s(mhat,dl); \
      _Pragma("unroll") for(int r=0;r<16;++r){P0[r]=fsub_s(P0[r],dl);P1[r]=fsub_s(P1[r],dl);} \
      _Pragma("unroll") for(int r=0;r<16;++r)negm[r]=-mhat; asm volatile("":"+v"(negm)); \
       } \
    _Pragma("unroll") for(int r=0;r<16;++r)P0[r]=__builtin_amdgcn_exp2f(P0[r]); }while(0)
  #define RESC() do{ if(resc){ asm volatile("s_waitcnt lgkmcnt(0)":::"memory"); \
      _Pragma("unroll") for(int d_=0;d_<2;++d_) _Pragma("unroll") for(int r=0;r<16;++r)o[d_][r]*=wsf[crow(r,hi)]; } }while(0)
  f32x16 pA0,pA1,pB0,pB1;
  int sl_prev=0,sl_cur=0,sl_next=SLOTB;
  #define ROT() do{sl_prev=sl_cur;sl_cur=sl_next;sl_next=(sl_next==(NSLOT-1)*SLOTB)?0:sl_next+SLOTB;}while(0)
  DMA_K(2,2*SLOTB);
  WAIT_BAR(3);
  { const f32x16 zc_=f32x16{}; qkt(pA0,pA1,Kbase,qr,zc_,r32,hi); }asm volatile("s_nop 15\n\ts_nop 7":"+v"(pA0),"+v"(pA1));ADDK(pA0,pA1,0);CMASK(pA0,pA1,0);
  START(pA0,pA1);
  _Pragma("unroll") for(int r=0;r<16;++r)pA1[r]=__builtin_amdgcn_exp2f(pA1[r]);
  WAIT_BAR(0);
  DMA_K(3,0);DMA_V(1,SLOTB);
  ROT();
  kload8(kf,kp0+sl_cur);
  WAIT_BAR(2);
  s16x4 vlo[8],vhi[8]; u32x4 pw0,pw1,pw2,pw3;
  #define PKW(P,B) cvtpk_s(P[B],P[B+1])
  #define PAF(k) __builtin_bit_cast(bf16x8,pw##k)
  #define VFR(i) (bf16x8){vlo[i][0],vlo[i][1],vlo[i][2],vlo[i][3],vhi[i][0],vhi[i][1],vhi[i][2],vhi[i][3]}
  #define PIN(x) asm volatile("":"+v"(x))
  #define MX3(a,b,c) __builtin_fmaxf(__builtin_fmaxf((a),(b)),(c))
  #define GAPA(MF,A0,A1,A2,A3,W0,W1,PW) do{ MF; sacc+=A0; sacc+=A1; sacc+=A2; sacc+=A3; PIN(sacc); W0; W1; PIN(PW); SBAR(); }while(0)
  #define EX(v) __builtin_amdgcn_exp2f(v)
  #define GAPB(MF,X,B) do{ MF; X[B]=EX(X[B]); X[B+1]=EX(X[B+1]); X[B+2]=EX(X[B+2]); X[B+3]=EX(X[B+3]); PIN(X); SBAR(); }while(0)
  #define VRD(i) do{ vlo[i]=vtr(vp_+(((i)>>2)*4096+((i)&3)*1024)); vhi[i]=vtr(vp_+(((i)>>2)*4096+((i)&3)*1024+512)); }while(0)
  #define KRD(G,j) do{ if(G){ kload2(kf,kp0+sl_next,j); SBAR(); } }while(0)
  #define STEP(C0,C1,P0,P1,t,GK,GV,GL) do{ SBAR(); \
    const lds_cptr vp_=vp0+sl_prev; \
    bf16x8 qa_=QP(0),qb_=QP(1); VRD(0); SBAR(); float sacc=(P0[0]+P0[1]); \
    GAPA(C0=__builtin_amdgcn_mfma_f32_32x32x16_bf16(kf[0],qa_,negm,0,0,0), P0[2],P0[3],P0[4],P0[5],     pw0[0]=PKW(P0,0), pw0[1]=PKW(P0,2), pw0); \
    VRD(4); SBAR(); GAPA(C1=__builtin_amdgcn_mfma_f32_32x32x16_bf16(kf[1],qa_,negm,0,0,0), P0[6],P0[7],P0[8],P0[9],     pw0[2]=PKW(P0,4), pw0[3]=PKW(P0,6), pw0); \
    qa_=QP(2); VRD(1); SBAR(); GAPA(C0=__builtin_amdgcn_mfma_f32_32x32x16_bf16(kf[2],qb_,C0,0,0,0),   P0[10],P0[11],P0[12],P0[13], pw1[0]=PKW(P0,8), pw1[1]=PKW(P0,10), pw1); \
    VRD(5); SBAR(); GAPA(C1=__builtin_amdgcn_mfma_f32_32x32x16_bf16(kf[3],qb_,C1,0,0,0),   P0[14],P0[15],P1[0],P1[1],   pw1[2]=PKW(P0,12),pw1[3]=PKW(P0,14), pw1); \
    qb_=QP(3); VRD(2); SBAR(); GAPA(C0=__builtin_amdgcn_mfma_f32_32x32x16_bf16(kf[4],qa_,C0,0,0,0),   P1[2],P1[3],P1[4],P1[5],     pw2[0]=PKW(P1,0), pw2[1]=PKW(P1,2), pw2); \
    VRD(6); SBAR(); GAPA(C1=__builtin_amdgcn_mfma_f32_32x32x16_bf16(kf[5],qa_,C1,0,0,0),   P1[6],P1[7],P1[8],P1[9],     pw2[2]=PKW(P1,4), pw2[3]=PKW(P1,6), pw2); \
    VRD(3); SBAR(); GAPA(C0=__builtin_amdgcn_mfma_f32_32x32x16_bf16(kf[6],qb_,C0,0,0,0),   P1[10],P1[11],P1[12],P1[13], pw3[0]=PKW(P1,8), pw3[1]=PKW(P1,10), pw3); \
    VRD(7); SBAR(); GAPA(C1=__builtin_amdgcn_mfma_f32_32x32x16_bf16(kf[7],qb_,C1,0,0,0),   P1[14],P1[15],0.f,0.f,       pw3[2]=PKW(P1,12),pw3[3]=PKW(P1,14), pw3); \
    l_reg+=sacc; \
    if(GK){DMA_K((t)+3,sl_cur);} if(GV){DMA_V((t)+1,sl_next);} \
    ADDK(C0,C1,t); CMASK(C0,C1,t); \
    { float a=MX3(C0[0],C0[1],C1[0]),b=MX3(C0[2],C0[3],C1[1]); a=MX3(a,C1[2],C1[3]); \
      _Pragma("unroll") for(int r=4;r<16;r+=4){a=MX3(a,C0[r],C0[r+1]);b=MX3(b,C0[r+2],C0[r+3]);a=MX3(a,C1[r],C1[r+1]);b=MX3(b,C1[r+2],C1[r+3]);} \
      float rm=__builtin_fmaxf(a,b); { auto rr=__builtin_amdgcn_permlane32_swap(__float_as_uint(rm),__float_as_uint(rm),false,false); rm=__builtin_fmaxf(__uint_as_float(rr[0]),__uint_as_float(rr[1])); } \
      resc=false; \
      if(__builtin_expect(__any(rm>(float)THRL),0)){ const float dl=__builtin_fmaxf(rm,0.f); mhat+=dl; \
        _Pragma("unroll") for(int r=0;r<16;++r){C0[r]-=dl;C1[r]-=dl;} \
        _Pragma("unroll") for(int r=0;r<16;++r)negm[r]=-mhat; asm volatile("":"+v"(negm)); \
         \
        const float f=__builtin_amdgcn_exp2f(-dl); l_reg*=f; if(hi==0)wsf[r32]=f; resc=true; } } \
    SBAR(); \
    GAPB(o[0]=__builtin_amdgcn_mfma_f32_32x32x16_bf16(PAF(0),VFR(0),o[0],0,0,0), C0,0); \
    GAPB(o[1]=__builtin_amdgcn_mfma_f32_32x32x16_bf16(PAF(0),VFR(4),o[1],0,0,0), C0,4); \
    KRD(GL,0); GAPB(o[0]=__builtin_amdgcn_mfma_f32_32x32x16_bf16(PAF(1),VFR(1),o[0],0,0,0), C0,8); \
    KRD(GL,1); GAPB(o[1]=__builtin_amdgcn_mfma_f32_32x32x16_bf16(PAF(1),VFR(5),o[1],0,0,0), C0,12); \
    KRD(GL,2); GAPB(o[0]=__builtin_amdgcn_mfma_f32_32x32x16_bf16(PAF(2),VFR(2),o[0],0,0,0), C1,0); \
    KRD(GL,3); GAPB(o[1]=__builtin_amdgcn_mfma_f32_32x32x16_bf16(PAF(2),VFR(6),o[1],0,0,0), C1,4); \
    GAPB(o[0]=__builtin_amdgcn_mfma_f32_32x32x16_bf16(PAF(3),VFR(3),o[0],0,0,0), C1,8); \
    GAPB(o[1]=__builtin_amdgcn_mfma_f32_32x32x16_bf16(PAF(3),VFR(7),o[1],0,0,0), C1,12); \
    }while(0)
  int t=1;
  #undef CMASK
  #define CMASK(P0,P1,t) do{}while(0)
  for(;t+5<NT;t+=2){
    STEP(pB0,pB1,pA0,pA1,t,true,true,true);     WAIT_BAR(2); RESC(); ROT();
    STEP(pA0,pA1,pB0,pB1,t+1,true,true,true);   WAIT_BAR(2); RESC(); ROT();
  }
  #undef CMASK
  #define CMASK(P0,P1,t) do{int jb_=(t)-band0; if(jb_>=0)cmask(P0,P1,jb_,qrel,hi);}while(0)
  #define ENDW(tt) do{ if((tt)+3<NT){WAIT_BAR(2);} else if((tt)+2<NT){WAIT_BAR(1);} else {WAIT_BAR(0);} }while(0)
  for(;t+1<NT;t+=2){
    STEP(pB0,pB1,pA0,pA1,t,(t+3<NT),(t+1<NT),(t+1<NT));       ENDW(t);   RESC(); ROT();
    STEP(pA0,pA1,pB0,pB1,t+1,(t+4<NT),(t+2<NT),(t+2<NT));     ENDW(t+1); RESC(); ROT();
  }
  STEP(pB0,pB1,pA0,pA1,NT-1,false,false,false); RESC();
  { float sacc=pB0[0]+pB0[1]; _Pragma("unroll") for(int r=2;r<16;++r)sacc+=pB0[r]; _Pragma("unroll") for(int r=0;r<16;++r)sacc+=pB1[r]; l_reg+=sacc;
    pw0=(u32x4){PKW(pB0,0),PKW(pB0,2),PKW(pB0,4),PKW(pB0,6)};pw1=(u32x4){PKW(pB0,8),PKW(pB0,10),PKW(pB0,12),PKW(pB0,14)};pw2=(u32x4){PKW(pB1,0),PKW(pB1,2),PKW(pB1,4),PKW(pB1,6)};pw3=(u32x4){PKW(pB1,8),PKW(pB1,10),PKW(pB1,12),PKW(pB1,14)};
    SBAR(); pv(o,vb0+sl_cur,PAF(0),PAF(1),PAF(2),PAF(3)); }
  #undef PKW
  #undef PAF
  #undef VFR
  #undef PIN
  #undef MX3
  #undef GAPA
  #undef GAPB
  #undef EX
  #undef VRD
  #undef KRD
  #undef STEP
  #undef ENDW
  {auto rr=__builtin_amdgcn_permlane32_swap(__float_as_uint(l_reg),__float_as_uint(l_reg),false,false);l_reg=__uint_as_float(rr[0])+__uint_as_float(rr[1]);}
  if(hi==0)wsf[32+r32]=l_reg;asm volatile("s_waitcnt lgkmcnt(0)":::"memory");
  float rli[16];
  #pragma unroll
  for(int r=0;r<16;++r)rli[r]=__builtin_amdgcn_rcpf(wsf[32+crow(r,hi)]);
  bf16*Ow=O+(rowbase+q0+wid*QBLK)*PO+h*D;
  { bf16*stg=(bf16*)(shm+LDS_OST)+wid*2048;
    #pragma unroll
    for(int r=0;r<16;++r){const int orow=crow(r,hi);
      #pragma unroll
      for(int d0=0;d0<2;++d0)stg[orow*64+d0*32+r32]=__float2bfloat16(o[d0][r]*rli[r]);}
    asm volatile("s_waitcnt lgkmcnt(0)":::"memory");
    #pragma unroll
    for(int i=0;i<4;++i){const int row=i*8+(lane>>3),ch=lane&7; const u32x4 v=*(const u32x4*)(stg+row*64+ch*8); if(q0+wid*QBLK+row<TTOK)ATTN_STORE16(Ow+(long)row*PO+ch*8,v);} }
  asm volatile("s_waitcnt lgkmcnt(0)\n\ts_barrier":::"memory");
  #undef ADDK
  #undef QP
  #undef DMA_K
  #undef DMA_V
  #undef CMASK
  #undef START
  #undef RESC
  #undef ROT
}
constexpr int QA_OFF=0,KA_OFF=512,VA_OFF=640;
__device__ __forceinline__ void swa_unit(int lb,int kvh,int a,const bf16*__restrict__ P,bf16*OC,const float*__restrict__ rel,const float*__restrict__ sinks,char*shm,int wv){
  const int tid=otid(wv),lane=tid&63,r32=lane&31,hi=lane>>5; const int wid=__builtin_amdgcn_readfirstlane(tid>>6);
  const int g=wid>>1,half=wid&1,hq=kvh*4+g;
  const long rowbase=(long)lb*TTOK;
  const unsigned lds0=(unsigned)(uintptr_t)shm; const lds_cptr shm3=(lds_cptr)shm;
  float*wsf=(float*)(shm+LDS_WS)+wid*64;
  const float LOG2E=1.4426950408889634f;
  { const int gg=tid>>7,d=tid&127; int bk=d; if(d>=16){ bk=16+(int)(logf((float)d*(1.f/16.f))*(16.f/2.0794415416798357f)); if(bk>31)bk=31; }
    ((__attribute__((address_space(3))) float*)(shm3+LDS_DK))[tid]=rel[bk*8+kvh*4+gg]*LOG2E; }
  const int t_lo=a>=2?a-2:0; const int ntile=a-t_lo+1;
  const bf16*Kh=P+rowbase*PQ+KA_OFF+kvh*64,*Vh=P+rowbase*PQ+VA_OFF+kvh*64;
  const bf16*ksrc=Kh+(long)lane*PQ+wid*8;
  const bf16*vsrc=Vh+(long)(16*(wid&3)+(lane>>2))*PQ+(wid>>2)*32+(lane&3)*8;
  #pragma unroll
  for(int j=0;j<3;++j) if(j<ntile){
    glds16(ksrc+(long)(t_lo+j)*KVBLK*PQ,(unsigned)__builtin_amdgcn_readfirstlane(lds0+LDS_K+wid*1024+j*SLOTB));
    glds16(vsrc+(long)(t_lo+j)*KVBLK*PQ,(unsigned)__builtin_amdgcn_readfirstlane(lds0+LDS_V+wid*1024+j*SLOTB)); }
  const int qpos=64*a+32*half+r32;
  const bf16*Qw=P+(rowbase+64*a+32*half)*PQ+QA_OFF+hq*64;
  bf16x8 qr[4];
  #pragma unroll
  for(int d0=0;d0<4;++d0)qr[d0]=*reinterpret_cast<const bf16x8*>(&Qw[(long)r32*PQ+d0*16+hi*8]);
  const float sink2=sinks[hq]*LOG2E;
  asm volatile("s_waitcnt vmcnt(0) lgkmcnt(0)\n\ts_barrier":::"memory");
  f32x16 S0[3],S1[3]; f32x16 zero=f32x16{};
  #pragma unroll
  for(int j=0;j<3;++j){ S0[j]=f32x16{}; S1[j]=f32x16{}; if(j<ntile){ qkt(S0[j],S1[j],shm+LDS_K+j*SLOTB,qr,zero,r32,hi); } }
  const __attribute__((address_space(3))) float* bt=(const __attribute__((address_space(3))) float*)(shm3+LDS_DK)+g*128;
  float mx=sink2;
  #pragma unroll
  for(int j=0;j<3;++j){
    #pragma unroll
    for(int r=0;r<16;++r){
      const int kv=64*(t_lo+j)+crow(r,hi); const int d0_=qpos-kv, d1_=d0_-32;
      const bool ok0=(j<ntile)&&(d0_>=0)&&(d0_<128), ok1=(j<ntile)&&(d1_>=0)&&(d1_<128);
      const float s0=ok0?S0[j][r]+bt[d0_&127]:-INFINITY, s1=ok1?S1[j][r]+bt[d1_&127]:-INFINITY;
      S0[j][r]=s0; S1[j][r]=s1; mx=fmaxf(mx,fmaxf(s0,s1)); } }
  mx=fmaxf(mx,bperm_f(lane^32,mx));
  float l=0.f;
  #pragma unroll
  for(int j=0;j<3;++j){
    #pragma unroll
    for(int r=0;r<16;++r){ const float p0=__builtin_amdgcn_exp2f(S0[j][r]-mx), p1=__builtin_amdgcn_exp2f(S1[j][r]-mx); S0[j][r]=p0; S1[j][r]=p1; l+=p0+p1; } }
  l+=bperm_f(lane^32,l); l+=__builtin_amdgcn_exp2f(sink2-mx);
  f32x16 o[2]; o[0]=f32x16{}; o[1]=f32x16{};
  const int vb0=(int)(lds0+LDS_V)+((lane>>4)&1)*32+(lane&3)*8+(4*hi+((lane&15)>>2))*64;
  #define PKW(P,B) cvtpk_s(P[B],P[B+1])
  #pragma unroll
  for(int j=0;j<3;++j) if(j<ntile){
    u32x4 pw0=(u32x4){PKW(S0[j],0),PKW(S0[j],2),PKW(S0[j],4),PKW(S0[j],6)},pw1=(u32x4){PKW(S0[j],8),PKW(S0[j],10),PKW(S0[j],12),PKW(S0[j],14)};
    u32x4 pw2=(u32x4){PKW(S1[j],0),PKW(S1[j],2),PKW(S1[j],4),PKW(S1[j],6)},pw3=(u32x4){PKW(S1[j],8),PKW(S1[j],10),PKW(S1[j],12),PKW(S1[j],14)};
    pv(o,vb0+j*SLOTB,__builtin_bit_cast(bf16x8,pw0),__builtin_bit_cast(bf16x8,pw1),__builtin_bit_cast(bf16x8,pw2),__builtin_bit_cast(bf16x8,pw3)); }
  #undef PKW
  if(hi==0)wsf[32+r32]=l; asm volatile("s_waitcnt lgkmcnt(0)":::"memory");
  float rli[16];
  #pragma unroll
  for(int r=0;r<16;++r)rli[r]=__builtin_amdgcn_rcpf(wsf[32+crow(r,hi)]);
  bf16*Ow=OC+(rowbase+64*a+32*half)*PO+hq*64;
  { bf16*stg=(bf16*)(shm+LDS_OST)+wid*2048;
    #pragma unroll
    for(int r=0;r<16;++r){const int orow=crow(r,hi);
      #pragma unroll
      for(int d0=0;d0<2;++d0)stg[orow*64+d0*32+r32]=__float2bfloat16(o[d0][r]*rli[r]);}
    asm volatile("s_waitcnt lgkmcnt(0)":::"memory");
    #pragma unroll
    for(int i=0;i<4;++i){const int row=i*8+(lane>>3),ch=lane&7; const u32x4 v=*(const u32x4*)(stg+row*64+ch*8); if(64*a+32*half+row<TTOK)*(u32x4*)(Ow+(long)row*PO+ch*8)=v;} }
  asm volatile("s_waitcnt lgkmcnt(0)\n\ts_barrier":::"memory");
}
#undef SBAR
#undef WAIT_BAR
}

#define GAS __attribute__((address_space(1)))
#define LAS __attribute__((address_space(3)))
typedef unsigned short bf16;
typedef unsigned v4u __attribute__((ext_vector_type(4)));
typedef float f32x4 __attribute__((ext_vector_type(4)));
typedef short bf16x8 __attribute__((ext_vector_type(8)));
typedef GAS unsigned gu32;
typedef GAS unsigned long long gu64;
#define RLX_AGENT __ATOMIC_RELAXED, __HIP_MEMORY_SCOPE_AGENT
#define LDS_WAIT() asm volatile("s_waitcnt lgkmcnt(0)" ::: "memory")
#define VM_WAIT() asm volatile("s_waitcnt vmcnt(0)" ::: "memory")
__device__ __forceinline__ unsigned long long rt() { return __builtin_amdgcn_s_memrealtime(); }
__device__ __forceinline__ unsigned f2bf(float f) { unsigned u = __builtin_bit_cast(unsigned, f); return (u + 0x7fffu + ((u >> 16) & 1u)) >> 16; }
__device__ __forceinline__ unsigned pk2(float lo, float hi) { return f2bf(lo) | (f2bf(hi) << 16); }

#define XB_TMO      128
#define XB_XCNT(j)  (256  + 64 * (j))
#define XB_XSUB(j)  (1280 + 64 * (j))
#define XB_XGEN(j)  (2304 + 64 * (j))
#define XB_TOP      3328
#define XB_TOPGEN   3392
#define XCD_BAR_WORDS 3456
#define XB_SPIN_CAP (1u << 18)

__device__ __forceinline__ unsigned xb_ld(unsigned* p)              { return __hip_atomic_load(p, __ATOMIC_RELAXED, __HIP_MEMORY_SCOPE_AGENT); }
__device__ __forceinline__ unsigned xb_add(unsigned* p, unsigned v) { return __hip_atomic_fetch_add(p, v, __ATOMIC_RELAXED, __HIP_MEMORY_SCOPE_AGENT); }
__device__ __forceinline__ unsigned xb_xcc_id() { return (unsigned)__builtin_amdgcn_s_getreg((3 << 11) | 20) & 0xFu; }
#define XB_SPIN(cond, bar) do { unsigned _sp = 0; while (cond) { __builtin_amdgcn_s_sleep(1); \
    if ((++_sp & 255u) == 0u) { if (xb_ld(&(bar)[XB_TMO])) break; if (_sp > XB_SPIN_CAP) { atomicAdd(&(bar)[XB_TMO], 1u); break; } } } } while (0)

struct XcdBarrier {
    unsigned* bar; unsigned x;
    volatile LAS unsigned* st;
};

__device__ __forceinline__ XcdBarrier xcd_barrier_post(unsigned* bar, volatile LAS unsigned* st) {
    XcdBarrier b; b.bar = bar; b.x = xb_xcc_id(); b.st = st;
    if (threadIdx.x == 0) (void)xb_add(&bar[XB_XCNT(b.x)], 1u);
    return b;
}
__device__ __forceinline__ void xcd_barrier_complete(unsigned* bar, unsigned x, unsigned& nloc, unsigned& nx) {
    const unsigned G = gridDim.x * gridDim.y * gridDim.z;
    unsigned sum, cnt, mine, sp = 0u;
    for (;;) {
        sum = 0u; cnt = 0u; mine = 0u;
#pragma unroll
        for (unsigned j = 0; j < 16; ++j) { const unsigned c = xb_ld(&bar[XB_XCNT(j)]); sum += c; cnt += (c > 0u) ? 1u : 0u; mine = (j == x) ? c : mine; }
        if (sum == G) break;
        __builtin_amdgcn_s_sleep(1);
        if ((++sp & 255u) == 0u) { if (xb_ld(&bar[XB_TMO])) break; if (sp > XB_SPIN_CAP) { atomicAdd(&bar[XB_TMO], 1u); break; } }
    }
    nloc = mine > 0u ? mine : 1u; nx = cnt > 0u ? cnt : 1u;
}

__device__ __forceinline__ void xcd_barrier(const XcdBarrier& b) {
    asm volatile("s_waitcnt vmcnt(0)" ::: "memory");
    __syncthreads();
    if (threadIdx.x == 0) {
        unsigned* bar = b.bar;
        __builtin_amdgcn_s_waitcnt(0);
        unsigned nloc = b.st[0], nx = b.st[1];
        if (nloc == 0u) { xcd_barrier_complete(bar, b.x, nloc, nx); b.st[0] = nloc; b.st[1] = nx; }
        const unsigned old = xb_add(&bar[XB_XSUB(b.x)], 1u);
        const unsigned gen = old / nloc;
        if (old + 1u == (gen + 1u) * nloc) {
            __builtin_amdgcn_fence(__ATOMIC_RELEASE, "agent");
            asm volatile("s_waitcnt vmcnt(0)" ::: "memory");
            const unsigned og = xb_add(&bar[XB_TOP], 1u);
            const unsigned tg = og / nx;
            if (og + 1u == (tg + 1u) * nx) xb_add(&bar[XB_TOPGEN], 1u);
            else XB_SPIN(xb_ld(&bar[XB_TOPGEN]) == tg, bar);
            __builtin_amdgcn_fence(__ATOMIC_ACQUIRE, "agent");
            xb_add(&bar[XB_XGEN(b.x)], 1u);
            asm volatile("s_waitcnt vmcnt(0)" ::: "memory");
        } else {
            XB_SPIN(xb_ld(&bar[XB_XGEN(b.x)]) == gen, bar);
            __builtin_amdgcn_fence(__ATOMIC_ACQUIRE, "agent");
            asm volatile("s_waitcnt vmcnt(0)" ::: "memory");
        }
    }
    __syncthreads();
}

constexpr int NWAVES = 8;
constexpr int T_TOK = 4112, M_TOK = 32896, DMODEL = 1024, NPROJ = 6656, DFF = 2816, MP = 33280;
constexpr int HALF_ROWS = 4 * T_TOK  , NT_HALF = 65, MLOC = 16896  ;
constexpr int QA_OFF = 0, KA_OFF = 512, VA_OFF = 640, QF_OFF = 768, KF_OFF = 1280, VF_OFF = 1792, XC_OFF = 2304, YC_OFF = 2816, GATE_OFF = 3328, FL_OFF = 6400;
constexpr int LRU_CH = 129;
constexpr float C2 = 0.125f * 1.4426950408889634f, LOG2E = 1.4426950408889634f;
constexpr size_t MiB = 1u << 20;
constexpr size_t WS_CTL = 0, CTL_ZERO_BYTES = 64 * 1024;
constexpr size_t WS_SSQA = 1 * MiB, WS_SSQB = WS_SSQA + 512 * 1024, WS_HMETA = 2 * MiB  , WS_FL = 3 * MiB  , WS_DK = 4 * MiB  ;
constexpr size_t WS_LRUP = 5 * MiB  , WS_LRUH = 7 * MiB;
constexpr size_t WS_WIN = 9 * MiB;
constexpr size_t WS_WB = WS_WIN + 13 * MiB;
constexpr size_t WS_WOUT = WS_WB + 3 * MiB;
constexpr size_t WS_WFFI = WS_WOUT + 2 * MiB;
constexpr size_t WS_WFFO = WS_WFFI + 11 * MiB;
constexpr size_t WS_WR = WS_WFFO + 6 * MiB, WS_WI = WS_WR + 65536;
constexpr size_t WS_PART = 44 * MiB + 256 * 1024;
constexpr size_t WS_HB = 46 * MiB;
constexpr size_t WS_MG = WS_HB + 65 * MiB;
constexpr size_t WS_OC = WS_MG + 65 * MiB;
constexpr size_t WS_PROJ = WS_OC + 50 * MiB;
constexpr size_t WS_W2ND = WS_PROJ + 215 * MiB;
constexpr size_t WS_WSET = WS_W2ND - WS_WIN;
constexpr size_t WS_PARTK = WS_W2ND + 37 * MiB;
constexpr size_t WS_END = WS_PARTK + 6 * MiB;
static_assert(WS_WI + 65536 <= WS_HB && (size_t)MP * 1024 * 2 <= 65 * MiB && (size_t)MLOC * 1536 * 2 <= 50 * MiB && (size_t)MLOC * NPROJ * 2 <= 215 * MiB && (size_t)MP * DFF * 2 <= 215 * MiB && WS_END <= 512 * MiB, "ws map");
constexpr int CW_TICK = 8192;
constexpr int CW_BAR = 4096;
constexpr int RING_BYTES = 131072, MISC_OFF = RING_BYTES + 320, LDS_BYTES = 147456;

using pg8::sigmoid_f;
struct Args { const float* in[20]; float* out; unsigned char* ws; int ph_lo, ph_hi; };
struct Frame {
    LAS unsigned char* lds; int tid, lane, wave, G, bid;
    float* out; unsigned char* ws;
};
__device__ __forceinline__ float wave_sum(float v, int lane) {
#pragma unroll
    for (int o = 1; o < 64; o <<= 1) v += bperm_f(lane ^ o, v);
    return v;
}
__device__ __forceinline__ float* hrow(const Frame& F, int m) { const int b = m / T_TOK, t = m - b * T_TOK; return (t < 16) ? (float*)(F.ws + WS_HMETA) + (size_t)(b * 16 + t) * DMODEL : F.out + ((size_t)b * 4096 + (t - 16)) * DMODEL; }

__device__ __forceinline__ void wt_item(const float* __restrict__ W, int ldn, int s0, int nv, int K, bf16* WT, int n0, const float* __restrict__ kscale, float cs, LAS float* scr, int kb, int lane) {
    const int k0 = 64 * kb;
    { const int c4 = (lane & 7) * 4, r0 = lane >> 3;
        f32x4 v[8]; float ks[8];
#pragma unroll
        for (int i = 0; i < 8; ++i) { const int kk = r0 + 8 * i; ks[i] = kscale ? kscale[k0 + kk] : 1.f;
            v[i] = *(const f32x4*)(W + (size_t)(k0 + kk) * ldn + s0 + (c4 < nv ? c4 : 0)); }
#pragma unroll
        for (int i = 0; i < 8; ++i) { const int kk = r0 + 8 * i; const float m_ = (c4 < nv) ? ks[i] * cs : 0.f;
            scr[kk * 33 + c4 + 0] = v[i][0] * m_; scr[kk * 33 + c4 + 1] = v[i][1] * m_; scr[kk * 33 + c4 + 2] = v[i][2] * m_; scr[kk * 33 + c4 + 3] = v[i][3] * m_; } }
    LDS_WAIT(); asm volatile("" ::: "memory");
    const int c = lane & 7;
#pragma unroll
    for (int j = 0; j < 4; ++j) { const int n = (lane >> 3) + 8 * j; const LAS float* s = scr + (8 * c) * 33 + n;
        v4u o; o.x = pk2(s[0 * 33], s[1 * 33]); o.y = pk2(s[2 * 33], s[3 * 33]); o.z = pk2(s[4 * 33], s[5 * 33]); o.w = pk2(s[6 * 33], s[7 * 33]);
        *(GAS v4u*)(WT + (size_t)(n0 + n) * K + k0 + 8 * c) = o; }
    LDS_WAIT(); asm volatile("" ::: "memory");
}
__device__ __forceinline__ void wconv_phase(Frame& F, int l, int skip, const float* norm_mix, const float* w_in, const float* lru_wr, const float* lru_wi, const float* w_branch, const float* w_out, const float* norm_ffn, const float* w_ffi, const float* w_ffo) {
    LAS float* scr = (LAS float*)(F.lds + F.wave * 16384);
    if (F.bid < skip) return;
    const int gw = (F.bid - skip) * NWAVES + F.wave, NGW = (F.G - skip) * NWAVES; const size_t wo = (l & 1) ? WS_WSET : 0;
    constexpr int I_IN = 16 * 208, I_FFI = 16 * 176, I_WB = 3 * 8 * 32, I_OUT = 16 * 32, I_FFO = 44 * 32, I_LRU = 2 * 8 * 2;
    constexpr int NITEMS = I_IN + I_FFI + I_WB + I_OUT + I_FFO + I_LRU;
    bf16* Win_t = (bf16*)(F.ws + wo + WS_WIN); bf16* Wb_t = (bf16*)(F.ws + wo + WS_WB); bf16* Wout_t = (bf16*)(F.ws + wo + WS_WOUT); bf16* Wffi_t = (bf16*)(F.ws + wo + WS_WFFI); bf16* Wffo_t = (bf16*)(F.ws + wo + WS_WFFO);
    for (int it = gw; it < NITEMS; it += NGW) {
        int r = it;
        if (r < I_IN) { const int kb = r / 208, nb = r % 208, n0 = 32 * nb; int s0, nv = 32; float cs = 1.f;
            if (n0 < 2304) { s0 = n0; if (n0 < 512 || (n0 >= 768 && n0 < 1280)) cs = C2; } else if (n0 < 6400) s0 = n0 + 8; else if (n0 == 6400) { s0 = 2304; nv = 8; } else { s0 = 0; nv = 0; }
            wt_item(w_in + (size_t)l * 1024 * 6408, 6408, s0, nv, 1024, Win_t, n0, norm_mix + l * 1024, cs, scr, kb, F.lane); continue; } r -= I_IN;
        if (r < I_FFI) { const int kb = r / 176, nb = r % 176, n0 = 32 * nb, pn = n0 >> 8, w = n0 & 255; const int s0 = (w < 128) ? 128 * pn + w : 2816 + 128 * pn + (w - 128);
            wt_item(w_ffi + (size_t)l * 1024 * 5632, 5632, s0, 32, 1024, Wffi_t, n0, norm_ffn + l * 1024, 1.f, scr, kb, F.lane); continue; } r -= I_FFI;
        if (r < I_WB) { const int g = r / 256, q = r % 256, kb = q / 32, nb = q % 32;
            wt_item(w_branch + (size_t)(l * 3 + g) * 512 * 1024, 1024, 32 * nb, 32, 512, Wb_t, g * 1024 + 32 * nb, nullptr, 1.f, scr, kb, F.lane); continue; } r -= I_WB;
        if (r < I_OUT) { const int kb = r / 32, nb = r % 32;
            wt_item(w_out + (size_t)l * 1024 * 1024, 1024, 32 * nb, 32, 1024, Wout_t, 32 * nb, nullptr, 1.f, scr, kb, F.lane); continue; } r -= I_OUT;
        if (r < I_FFO) { const int kb = r / 32, nb = r % 32;
            wt_item(w_ffo + (size_t)l * 2816 * 1024, 1024, 32 * nb, 32, 2816, Wffo_t, 32 * nb, nullptr, 1.f, scr, kb, F.lane); continue; } r -= I_FFO;
        { const int mat = r / 16, q = r % 16, h = q / 2, nb = q % 2;
            wt_item((mat ? lru_wi : lru_wr) + (size_t)(l * 8 + h) * 4096, 64, 32 * nb, 32, 64, (bf16*)(F.ws + wo + (mat ? WS_WI : WS_WR)) + h * 4096, 32 * nb, nullptr, 1.f, scr, 0, F.lane); }
    }
}
__device__ __forceinline__ void init_phase(Frame& F, const float* x, const float* meta) {
    const int gw = F.bid * NWAVES + F.wave, NGW = F.G * NWAVES;
    bf16* hb = (bf16*)(F.ws + WS_HB); unsigned long long* ssqA = (unsigned long long*)(F.ws + WS_SSQA); unsigned long long* ssqB = (unsigned long long*)(F.ws + WS_SSQB);
    for (int m = gw; m < MP; m += NGW) {
        GAS unsigned long long* o8 = (GAS unsigned long long*)(hb + (size_t)m * DMODEL) + F.lane;
        if (m < M_TOK) { const int b = m / T_TOK, t = m - b * T_TOK;
            const float* src = (t < 16) ? meta + (size_t)t * DMODEL : x + ((size_t)b * 4096 + (t - 16)) * DMODEL;
            const GAS f32x4* xr = (const GAS f32x4*)src + F.lane; GAS f32x4* hr = (GAS f32x4*)hrow(F, m) + F.lane;
            float s = 0.f;
#pragma unroll
            for (int j = 0; j < 4; ++j) { const f32x4 v = xr[64 * j]; hr[64 * j] = v; s += (v.x * v.x + v.y * v.y) + (v.z * v.z + v.w * v.w);
                o8[64 * j] = (unsigned long long)pk2(v.x, v.y) | ((unsigned long long)pk2(v.z, v.w) << 32); }
            s = wave_sum(s, F.lane); if (F.lane == 0) { unsigned long long z = 0ull; asm volatile("" : "+v"(z)); ssqB[m] = (unsigned long long)(s * 1048576.0f); ssqA[m] = z; }
        } else {
            unsigned long long z = 0ull; asm volatile("" : "+v"(z));
#pragma unroll
            for (int j = 0; j < 4; ++j) o8[64 * j] = z;
            if (F.lane == 0) { ssqB[m] = z; ssqA[m] = z; }
        }
    }
}
__device__ __forceinline__ void final_phase(Frame& F, const float* norm_final) {
    const int gw = F.bid * NWAVES + F.wave, NGW = F.G * NWAVES; const unsigned long long* ssqB = (const unsigned long long*)(F.ws + WS_SSQB);
    for (int r = gw; r < 32768; r += NGW) { const int b = r >> 12, tt = r & 4095, m = b * T_TOK + 16 + tt;
        const float s = rsqrtf((float)ssqB[m] * (1.0f / (1024.0f * 1048576.0f)) + 1e-6f);
        GAS f32x4* hr = (GAS f32x4*)(F.out + (size_t)r * DMODEL) + F.lane; const GAS f32x4* gr = (const GAS f32x4*)norm_final + F.lane;
#pragma unroll
        for (int j = 0; j < 4; ++j) { f32x4 v = hr[64 * j]; const f32x4 g = gr[64 * j]; v = v * s * g; hr[64 * j] = v; } }
}
__device__ __forceinline__ void zero_u64(Frame& F, unsigned long long* p, int n) { unsigned long long z = 0ull; asm volatile("" : "+v"(z)); for (int i = F.bid * NWAVES * 64 + F.tid; i < n; i += F.G * NWAVES * 64) p[i] = z; }

__device__ __forceinline__ void fixup_phase(Frame& F) {
    if (F.bid >= 2) return;
    const int half = F.bid; const bf16* part = (const bf16*)(F.ws + WS_PART) + (size_t)half * 3 * 64 * 1024; bf16* mg = (bf16*)(F.ws + WS_MG) + (size_t)(half * HALF_ROWS + 16384) * DMODEL;
    for (int i = F.tid; i < 64 * 128; i += NWAVES * 64) { const v4u a = *(const v4u*)(part + (size_t)i * 8), b = *(const v4u*)(part + 65536 + (size_t)i * 8), c = *(const v4u*)(part + 131072 + (size_t)i * 8);
        v4u o;
#define FX_(f) o.f = pk2(__uint_as_float(a.f << 16) + __uint_as_float(b.f << 16) + __uint_as_float(c.f << 16), __uint_as_float(a.f & 0xffff0000u) + __uint_as_float(b.f & 0xffff0000u) + __uint_as_float(c.f & 0xffff0000u))
        FX_(x); FX_(y); FX_(z); FX_(w);
#undef FX_
        *(v4u*)(mg + (size_t)i * 8) = o; }
}
__device__ __forceinline__ void fixk_phase(Frame& F, int npieces, unsigned long long* ssq) {
    if (F.bid >= 128) return;
    const int grow = 32768 + F.bid, c = 2 * F.tid; typedef float f32x2v __attribute__((ext_vector_type(2)));
    const float* pk = (const float*)(F.ws + WS_PARTK) + (size_t)F.bid * DMODEL + c; float* hp = hrow(F, grow) + c;
    f32x2v a = *(const f32x2v*)hp;
    for (int p = 0; p < npieces; ++p) a += *(const f32x2v*)(pk + (size_t)p * 128 * DMODEL);
    *(f32x2v*)hp = a; *(unsigned*)((bf16*)(F.ws + WS_HB) + (size_t)grow * DMODEL + c) = pk2(a.x, a.y);
    const float s = wave_sum(a.x * a.x + a.y * a.y, F.lane);
    if (F.lane == 0) atomicAdd(ssq + grow, (unsigned long long)(s * 1048576.0f));
}
__device__ __forceinline__ float logsig_f(float x) { return fminf(x, 0.f) - __logf(1.f + __expf(-fabsf(x))); }
__device__ __forceinline__ float one_minus_exp(float x) { const float s = -x * (1.f + x * (0.5f + x * 0.16666667f)); const float e = 1.f - __expf(x); return (x > -1e-3f) ? s : e; }
__device__ __forceinline__ void cumsum_unit(Frame& F, int l, int lb, const float* fbias) {
    const int h = F.wave, lane = F.lane; const float* fl = (const float*)(F.ws + WS_FL); float* dk = (float*)(F.ws + WS_DK) + (size_t)(lb * 8 + h) * 4352;
    const float fb = fbias[l * 8 + h]; float carry = 0.f;
    for (int cq = 0; cq < 17; ++cq) { const int t0 = 256 * cq + 4 * lane; float v[4];
#pragma unroll
        for (int j = 0; j < 4; ++j) { const int t = t0 + j; const float x = fl[(size_t)(lb * T_TOK + (t < T_TOK ? t : T_TOK - 1)) * 8 + h]; const float lv = logsig_f(x + fb); v[j] = (t < T_TOK) ? lv : 0.f; }
        v[1] += v[0]; v[2] += v[1]; v[3] += v[2];
        float inc = v[3];
#pragma unroll
        for (int o = 1; o < 64; o <<= 1) { const float u = bperm_f(lane - o, inc); if (lane >= o) inc += u; }
        const float ex = carry + inc - v[3];
        f32x4 o4 = { -(ex + v[0]) * LOG2E, -(ex + v[1]) * LOG2E, -(ex + v[2]) * LOG2E, -(ex + v[3]) * LOG2E };
        *(f32x4*)(dk + t0) = o4;
        carry += bperm_f(63, inc);
    }
}
__device__ __forceinline__ float bf2f(unsigned short u) { return __uint_as_float((unsigned)u << 16); }
__device__ __forceinline__ int crow_(int r, int hi) { return (r & 3) + 8 * (r >> 2) + 4 * hi; }
template <int MODE> __device__ __forceinline__ void lru_unit(Frame& F, int l, int lb, int ch, const float* conv_w, const float* conv_b, const float* lru_br, const float* lru_bi, const float* lam) {
    typedef float f32x16 __attribute__((ext_vector_type(16)));
    const int tid = F.tid, wid = F.wave, lane = F.lane, c = tid, r32 = lane & 31, hi = lane >> 5;
    const bf16* proj = (const bf16*)(F.ws + WS_PROJ);
    const int t0 = ch * 32, nt = (T_TOK - t0) < 32 ? (T_TOK - t0) : 32;
    LAS unsigned short* XCb = (LAS unsigned short*)(F.lds);
    LAS float* MU = (LAS float*)(F.lds);
    LAS float* AS = (LAS float*)(F.lds + 65536);
    LAS unsigned short* XR = (LAS unsigned short*)(F.lds + 65536);
    const unsigned lds0 = (unsigned)(uintptr_t)(unsigned char*)F.lds;
    { const bf16* rowp = proj + (size_t)(lb * T_TOK) * NPROJ + XC_OFF + lane * 8;
#pragma unroll
        for (int i = 0; i < 5; ++i) { const int row = wid + 8 * i; if (row < 35) { int tt = t0 - 3 + row; tt = tt < 0 ? 0 : tt;
            attn_body::glds16(rowp + (size_t)tt * NPROJ, (unsigned)__builtin_amdgcn_readfirstlane(lds0 + 65536 + row * 1024)); } }
    }
    bf16x8 wbr[2][4], wbi[2][4];
    { const size_t wo = (l & 1) ? WS_WSET : 0; const bf16* Wr = (const bf16*)(F.ws + wo + WS_WR) + wid * 4096; const bf16* Wi = (const bf16*)(F.ws + wo + WS_WI) + wid * 4096;
#pragma unroll
        for (int jt = 0; jt < 2; ++jt)
#pragma unroll
            for (int ks = 0; ks < 4; ++ks) { wbr[jt][ks] = *(const bf16x8*)(Wr + (jt * 32 + r32) * 64 + 16 * ks + 8 * hi); wbi[jt][ks] = *(const bf16x8*)(Wi + (jt * 32 + r32) * 64 + 16 * ks + 8 * hi); } }
    const float w0 = conv_w[(l * 4 + 0) * 512 + c], w1 = conv_w[(l * 4 + 1) * 512 + c], w2 = conv_w[(l * 4 + 2) * 512 + c], w3 = conv_w[(l * 4 + 3) * 512 + c], cb = conv_b[l * 512 + c];
    asm volatile("s_waitcnt vmcnt(0)" ::: "memory"); __syncthreads();
    float xcv[32];
    { const float m3 = (t0 >= 3) ? 1.f : 0.f;
        float xm3 = bf2f(XR[0 * 512 + c]) * m3, xm2 = bf2f(XR[1 * 512 + c]) * m3, xm1 = bf2f(XR[2 * 512 + c]) * m3;
#pragma unroll
        for (int t = 0; t < 32; ++t) { const float x0 = bf2f(XR[(t + 3) * 512 + c]);
            xcv[t] = w0 * xm3 + w1 * xm2 + w2 * xm1 + w3 * x0 + cb; xm3 = xm2; xm2 = xm1; xm1 = x0;
            XCb[t * 520 + c] = (unsigned short)f2bf(xcv[t]); } }
    __syncthreads();
    bf16x8 af[4];
#pragma unroll
    for (int ks = 0; ks < 4; ++ks) af[ks] = *(const LAS bf16x8*)(XCb + r32 * 520 + 64 * wid + 16 * ks + 8 * hi);
    __syncthreads();
    f32x16 dr[2], di[2];
    {
#pragma unroll
        for (int jt = 0; jt < 2; ++jt) { dr[jt] = f32x16{}; di[jt] = f32x16{};
#pragma unroll
            for (int ks = 0; ks < 4; ++ks) { dr[jt] = __builtin_amdgcn_mfma_f32_32x32x16_bf16(af[ks], wbr[jt][ks], dr[jt], 0, 0, 0); di[jt] = __builtin_amdgcn_mfma_f32_32x32x16_bf16(af[ks], wbi[jt][ks], di[jt], 0, 0, 0); } } }
#pragma unroll
    for (int jt = 0; jt < 2; ++jt) { const int cc = 64 * wid + 32 * jt + r32; const float brv = lru_br[l * 512 + cc], biv = lru_bi[l * 512 + cc], lsl = 8.0f * logsig_f(lam[l * 512 + cc]);
#pragma unroll
        for (int r = 0; r < 16; ++r) { const int t = crow_(r, hi); const float rr = sigmoid_f(dr[jt][r] + brv), gi = sigmoid_f(di[jt][r] + biv), la = rr * lsl;
            AS[t * 512 + cc] = __expf(la); MU[t * 512 + cc] = __builtin_amdgcn_sqrtf(one_minus_exp(2.0f * la)) * gi; } }
    __syncthreads();
    float* lp = (float*)(F.ws + WS_LRUP) + (size_t)(lb * LRU_CH) * 512 + c; float* lh = (float*)(F.ws + WS_LRUH) + (size_t)(lb * LRU_CH) * 512 + c;
    float h = 0.f, pa = 1.f;
    if (MODE == 1) {
        for (int k0 = 0; k0 < ch; k0 += 16) { float pv_[16], hv_[16];
#pragma unroll
            for (int j = 0; j < 16; ++j) { const int k = (k0 + j < ch) ? k0 + j : ch - 1; pv_[j] = lp[(size_t)k * 512]; hv_[j] = lh[(size_t)k * 512]; }
#pragma unroll
            for (int j = 0; j < 16; j += 4) asm volatile("" :: "v"(pv_[j]), "v"(pv_[j + 1]), "v"(pv_[j + 2]), "v"(pv_[j + 3]), "v"(hv_[j]), "v"(hv_[j + 1]), "v"(hv_[j + 2]), "v"(hv_[j + 3]));
#pragma unroll
            for (int j = 0; j < 16; ++j) { const bool ok = k0 + j < ch; const float hn = pv_[j] * h + hv_[j]; h = ok ? hn : h; } }
    }
#pragma unroll
    for (int t = 0; t < 32; ++t) { const float a = AS[t * 512 + c]; const float hn = a * h + MU[t * 512 + c] * xcv[t]; const bool ok = t < nt; h = ok ? hn : h; pa = ok ? pa * a : pa; if (MODE == 1) MU[t * 512 + c] = hn; }
    if (MODE == 0) { lp[(size_t)ch * 512] = pa; lh[(size_t)ch * 512] = h; }
    __syncthreads();
    if (MODE == 1) {
        { const bf16* rowp = proj + (size_t)(lb * T_TOK + t0) * NPROJ + YC_OFF + lane * 8;
#pragma unroll
            for (int i = 0; i < 4; ++i) { const int row = wid + 8 * i; attn_body::glds16(rowp + (size_t)row * NPROJ, (unsigned)__builtin_amdgcn_readfirstlane(lds0 + 65536 + row * 1024)); } }
        asm volatile("s_waitcnt vmcnt(0)" ::: "memory"); __syncthreads();
        bf16* op = (bf16*)(F.ws + WS_OC) + (size_t)(lb * T_TOK + t0 + wid) * 1536 + 1024 + lane * 8;
        unsigned yo = 65536 + wid * 1024 + lane * 16, ho = wid * 2048 + lane * 32; int row = wid;
#pragma unroll 1
        for (int pss = 0; pss < 4; ++pss, op += 8 * 1536, yo += 8192, ho += 16384, row += 8) {
            const v4u yw = *(const LAS v4u*)(F.lds + yo);
            const f32x4 h0 = *(const LAS f32x4*)(F.lds + ho), h1 = *(const LAS f32x4*)(F.lds + ho + 16);
            float y[8] = { __uint_as_float(yw.x << 16), __uint_as_float(yw.x & 0xffff0000u), __uint_as_float(yw.y << 16), __uint_as_float(yw.y & 0xffff0000u),
                           __uint_as_float(yw.z << 16), __uint_as_float(yw.z & 0xffff0000u), __uint_as_float(yw.w << 16), __uint_as_float(yw.w & 0xffff0000u) };
            float o[8];
#pragma unroll
            for (int j = 0; j < 8; ++j) { const float u = 0.7978845608028654f * (y[j] + 0.044715f * y[j] * y[j] * y[j]);
                const float th = 1.f - 2.f * __builtin_amdgcn_rcpf(1.f + __expf(2.f * u)); o[j] = 0.5f * y[j] * (1.f + th) * (j < 4 ? h0[j & 3] : h1[j & 3]); }
            v4u ow; ow.x = pk2(o[0], o[1]); ow.y = pk2(o[2], o[3]); ow.z = pk2(o[4], o[5]); ow.w = pk2(o[6], o[7]);
            if (row < nt) *(v4u*)op = ow; }
        __syncthreads();
    }
}

#ifndef ONE_LAUNCH
#define ONE_LAUNCH 1
#endif
#define INP(k) karg_ptr(8 * (k))
#ifndef DUP
#define DUP -1
#endif
__device__ __forceinline__ int nrep_of(int code) { int n = (DUP == code) ? 2 : 1; if (DUP == code) asm volatile("" : "+s"(n)); return n; }
#define NREP(code) for (int rep_ = 0, nr_ = nrep_of(code); rep_ < nr_; ++rep_)
enum { ST_INIT = 0, ST_WCONV, ST_G1, ST_S1, ST_S2, ST_S3, ST_G4, ST_G5, ST_G6, ST_FINAL, ST_FIX, ST_FIXK4, ST_FIXK6 };
__device__ __forceinline__ void make_frame(Frame& F, unsigned char* lds, int wv) {
    unsigned lb_ = (unsigned)(uintptr_t)(LAS unsigned char*)lds; asm volatile("" : "+s"(lb_));
    int g_ = gridDim.x, b_ = blockIdx.x; asm volatile("" : "+s"(g_), "+s"(b_));
    F.lds = (LAS unsigned char*)(uintptr_t)lb_; F.tid = otid(wv); F.lane = F.tid & 63; F.wave = __builtin_amdgcn_readfirstlane(F.tid >> 6); F.G = g_; F.bid = b_;
    F.out = (float*)karg_ptr(160); F.ws = (unsigned char*)karg_ptr(168);
}
template <int ST> __device__ __forceinline__ void run_stage(unsigned char* lds, int l, int half, int wv, int rep = 1) {
    Frame F; make_frame(F, lds, wv);
    unsigned char* ws = F.ws;
    bf16* hb = (bf16*)(ws + WS_HB); bf16* mg = (bf16*)(ws + WS_MG); bf16* oc = (bf16*)(ws + WS_OC); bf16* proj = (bf16*)(ws + WS_PROJ);
    unsigned long long* ssqA = (unsigned long long*)(ws + WS_SSQA); unsigned long long* ssqB = (unsigned long long*)(ws + WS_SSQB);
    const int grow0 = half * HALF_ROWS; const size_t wo = (l & 1) ? WS_WSET : 0;
    if constexpr (ST == ST_INIT) { init_phase(F, INP(0), INP(1)); }
    if constexpr (ST == ST_INIT || ST == ST_WCONV) { wconv_phase(F, l, 0, INP(3), INP(4), INP(9), INP(11), INP(14), INP(15), INP(16), INP(17), INP(18)); }
    if constexpr (ST == ST_FINAL) { final_phase(F, INP(19)); }
    if constexpr (ST == ST_FIX) { fixup_phase(F); }
    if constexpr (ST == ST_FIXK4) { fixk_phase(F, 4, ssqA); }
    if constexpr (ST == ST_FIXK6) { fixk_phase(F, 11, ssqB); }
    if constexpr (ST == ST_G1) {
                    pg8::Gemm g{(const pg8::bf16_t*)(hb + (size_t)grow0 * DMODEL), (const pg8::bf16_t*)(ws + wo + WS_WIN)};
                    typedef pg8::Order<NT_HALF, 26, 1> Ord; Ord S; S.init(F.G, F.bid);
                    pg8::EpiProj E{(pg8::bf16_t*)proj, (float*)(ws + WS_FL), ssqB, grow0};

pg8::gemm_phase<pg8::EpiProj, Ord, true, true, 1024, 1024, 0, 0>(F.lds, g, S, E, wv);
    }
    if constexpr (ST == ST_S1) {
        constexpr int N_SWA = 4 * 2 * 65, N_LRU = 4 * LRU_CH, N_CS = 4;
        NREP(32) for (int u = F.bid - 128; u >= 0 && u < N_CS; u += F.G) cumsum_unit(F, l, u, INP(6));
        NREP(30) for (int u = F.bid; u < N_SWA; u += F.G) { const int lb = u / 130, w = u % 130;
            attn_body::swa_unit(lb, w / 65, w % 65, (const attn_body::bf16*)proj, (attn_body::bf16*)oc, INP(2), INP(5) + l * 8, (char*)lds, wv); }
        NREP(31) for (int u = F.G - 1 - F.bid; u < N_LRU; u += F.G) lru_unit<0>(F, l, u / LRU_CH, u % LRU_CH, INP(7), INP(8), INP(10), INP(12), INP(13));
    }
    if constexpr (ST == ST_S2) {
        constexpr int N_LRU = 4 * LRU_CH, N_FOX = 4 * 8 * 17, N_ALL = N_LRU + N_FOX;
        unsigned* tick = (unsigned*)(ws + WS_CTL) + CW_TICK + 64 * ((l * 2 + half) * 2 + (rep & 1));
        volatile LAS unsigned* tl = (volatile LAS unsigned*)(F.lds + MISC_OFF) + 16;
#define NEXT_TICKET(t_) do { if (F.tid == 0) *tl = __hip_atomic_fetch_add(tick, 1u, __ATOMIC_RELAXED, __HIP_MEMORY_SCOPE_AGENT); __syncthreads(); t_ = (int)__builtin_amdgcn_readfirstlane(*tl); __syncthreads(); } while (0)
        int t; NEXT_TICKET(t);
        while (t < N_LRU) { lru_unit<1>(F, l, t / LRU_CH, t % LRU_CH, INP(7), INP(8), INP(10), INP(12), INP(13)); NEXT_TICKET(t); }
        while (t < N_ALL) { const int u = t - N_LRU; const int qb = 16 - u / 32, bh = u % 32, lb = bh >> 3, h = bh & 7;
            attn_body::attn_unit<24>(lb, h, qb, (const attn_body::bf16*)proj + QF_OFF, (const attn_body::bf16*)proj + KF_OFF, (const attn_body::bf16*)proj + VF_OFF, (attn_body::bf16*)oc + 512,
                                    (const float*)(ws + WS_DK) + (size_t)(lb * 8 + h) * 4352, (char*)lds, wv);
            NEXT_TICKET(t); }
#undef NEXT_TICKET
    }
    if constexpr (ST == ST_S3) {
                    pg8::Gemm g{(const pg8::bf16_t*)oc, (const pg8::bf16_t*)(ws + wo + WS_WB)};
                    typedef pg8::OrderS3 Ord; Ord S; S.init(F.G, F.bid);
                    pg8::EpiBranch E{(const pg8::bf16_t*)proj, (pg8::bf16_t*)(mg + (size_t)grow0 * DMODEL), (pg8::bf16_t*)(ws + WS_PART) + (size_t)half * 3 * 64 * 1024};

pg8::gemm_phase<pg8::EpiBranch, Ord, true, true, 512, 1536, 512, 4>(F.lds, g, S, E, wv);
    }
    if constexpr (ST == ST_G4) {
                zero_u64(F, ssqB, MP);
                pg8::Gemm g{(const pg8::bf16_t*)mg, (const pg8::bf16_t*)(ws + wo + WS_WOUT)};
                typedef pg8::OrderTailK<4> Ord; Ord S; S.init(F.G, F.bid);
                pg8::EpiRes E{F.out, (float*)(ws + WS_HMETA), (pg8::bf16_t*)hb, ssqA, (float*)(ws + WS_PARTK), (DUP == ST && rep == 0) ? 0.f : 1.f};

pg8::gemm_phase<pg8::EpiRes, Ord, true, true, 1024, 1024, 0, 0, 256>(F.lds, g, S, E, wv);
    }
    if constexpr (ST == ST_G5) {
                pg8::Gemm g{(const pg8::bf16_t*)hb, (const pg8::bf16_t*)(ws + wo + WS_WFFI)};
                typedef pg8::Order<129, 22, 1> Ord; Ord S; S.init(F.G, F.bid);
                pg8::EpiSwiglu E{(pg8::bf16_t*)proj, ssqA};

pg8::gemm_phase<pg8::EpiSwiglu, Ord, true, true, 1024, 1024, 0, 0>(F.lds, g, S, E, wv);
                if (l < 3 && rep != 0) wconv_phase(F, l + 1, 22, INP(3), INP(4), INP(9), INP(11), INP(14), INP(15), INP(16), INP(17), INP(18));
    }
    if constexpr (ST == ST_G6) {
                zero_u64(F, ssqA, MP);
                pg8::Gemm g{(const pg8::bf16_t*)proj, (const pg8::bf16_t*)(ws + wo + WS_WFFO)};
                typedef pg8::OrderTailK<11> Ord; Ord S; S.init(F.G, F.bid);
                pg8::EpiRes E{F.out, (float*)(ws + WS_HMETA), (pg8::bf16_t*)hb, ssqB, (float*)(ws + WS_PARTK), (DUP == ST && rep == 0) ? 0.f : 1.f};

pg8::gemm_phase<pg8::EpiRes, Ord, true, true, 2816, 2816, 0, 0, 256>(F.lds, g, S, E, wv);
    }
}
template <int ST> __global__ void __launch_bounds__(NWAVES * 64, 2) k_stage(Args args, int l, int half) {
    extern __shared__ __attribute__((aligned(16))) unsigned char lds[];
    run_stage<ST>(lds, l, half, __builtin_amdgcn_readfirstlane(threadIdx.x >> 6));
}

#if ONE_LAUNCH
#define RUN(ST, l_, h_) do { int nrep_ = (DUP == ST) ? 2 : 1; if (DUP == ST) asm volatile("" : "+s"(nrep_)); for (int rep_ = 0; rep_ < nrep_; ++rep_) { run_stage<ST>(lds, l_, h_, wv, (DUP == ST) ? rep_ : 1); SEAM(); } } while (0)
#define SEAM() do { XcdBarrier b_; b_.bar = (unsigned*)((unsigned char*)karg_ptr(168) + WS_CTL) + CW_BAR; { unsigned x_ = xb_xcc_id(); asm volatile("" : "+s"(x_)); b_.x = x_; } b_.st = MISC + 8; xcd_barrier(b_); } while (0)
__global__ void __launch_bounds__(NWAVES * 64, 2) fwd_kernel(Args args) {
    extern __shared__ __attribute__((aligned(16))) unsigned char lds[];
    const int wv = __builtin_amdgcn_readfirstlane(threadIdx.x >> 6);
    volatile LAS unsigned* MISC = (volatile LAS unsigned*)((LAS unsigned char*)lds + MISC_OFF);
    for (int u = threadIdx.x; u < (LDS_BYTES - RING_BYTES) / 4; u += NWAVES * 64) ((LAS unsigned*)((LAS unsigned char*)lds + RING_BYTES))[u] = 0u;
    __syncthreads();
    (void)xcd_barrier_post((unsigned*)(args.ws + WS_CTL) + CW_BAR, MISC + 8);
    run_stage<ST_INIT>(lds, 0, 0, wv);
    __threadfence(); cooperative_groups::this_grid().sync(); SEAM();
#define HALF_(l_, h_) RUN(ST_G1, l_, h_); RUN(ST_S1, l_, h_); RUN(ST_S2, l_, h_); RUN(ST_S3, l_, h_);
#define LAYER_(l_) HALF_(l_, 0) HALF_(l_, 1) RUN(ST_FIX, l_, 0); RUN(ST_G4, l_, 0); RUN(ST_FIXK4, l_, 0); RUN(ST_G5, l_, 0); RUN(ST_G6, l_, 0); RUN(ST_FIXK6, l_, 0);
    LAYER_(0) LAYER_(1) LAYER_(2) LAYER_(3)
    run_stage<ST_FINAL>(lds, 0, 0, wv);
}
#endif
template <int ST> static void launch_stage(const Args& a, int l, int half, int grid, hipStream_t stream) {
    static bool attr = false;
    if (!attr) { (void)hipFuncSetAttribute((const void*)k_stage<ST>, hipFuncAttributeMaxDynamicSharedMemorySize, LDS_BYTES); attr = true; }
    hipLaunchKernelGGL(k_stage<ST>, dim3(grid), dim3(NWAVES * 64), LDS_BYTES, stream, a, l, half);
}
extern "C" void kernel_launch(void* const* d_in, const int* in_sizes, int n_in, void* d_out, int out_size, void* d_ws, size_t ws_size, hipStream_t stream) {
    static int grid = 0;
    if (grid == 0) {
        if (n_in != 20 || out_size != 32768 * 1024 || ws_size < WS_END) { fprintf(stderr, "kernel_launch: unexpected shapes (n_in %d out %d ws %zu need %zu)\n", n_in, out_size, ws_size, (size_t)WS_END); grid = -1; return; }
        int dev = 0, cus = 0;
        (void)hipGetDevice(&dev); (void)hipDeviceGetAttribute(&cus, hipDeviceAttributeMultiprocessorCount, dev);
        grid = cus > 0 ? cus : 256;
    }
    if (grid < 0) return;
    (void)hipMemsetAsync((char*)d_ws + WS_CTL, 0, CTL_ZERO_BYTES, stream);
    Args a{};
    for (int i = 0; i < 20; ++i) a.in[i] = (const float*)d_in[i];
    a.out = (float*)d_out; a.ws = (unsigned char*)d_ws;
#if ONE_LAUNCH
    static bool attr = false;
    if (!attr) { (void)hipFuncSetAttribute((const void*)fwd_kernel, hipFuncAttributeMaxDynamicSharedMemorySize, LDS_BYTES); attr = true; }
    void* kargs[] = {&a};
    hipError_t e = hipLaunchCooperativeKernel((const void*)fwd_kernel, dim3(grid), dim3(NWAVES * 64), kargs, LDS_BYTES, stream);
    if (e != hipSuccess) fprintf(stderr, "cooperative launch failed: %s (grid %d)\n", hipGetErrorString(e), grid);
#else
    launch_stage<ST_INIT>(a, 0, 0, grid, stream);
    for (int l = 0; l < 4; ++l) {
        if (l > 0) launch_stage<ST_WCONV>(a, l, 0, grid, stream);
        for (int half = 0; half < 2; ++half) { launch_stage<ST_G1>(a, l, half, grid, stream); launch_stage<ST_S1>(a, l, half, grid, stream); launch_stage<ST_S2>(a, l, half, grid, stream); launch_stage<ST_S3>(a, l, half, grid, stream); }
        launch_stage<ST_G4>(a, l, 0, grid, stream); launch_stage<ST_G5>(a, l, 0, grid, stream); launch_stage<ST_G6>(a, l, 0, grid, stream);
    }
    launch_stage<ST_FINAL>(a, 0, 0, grid, stream);
#endif
}
```
